# Optimizing an MI355X kernel written in HIP

```python
import math
import jax, jax.numpy as jnp
from jax import lax
import numpy as np

D_MODEL = 1024
BATCH = 1
SEQ = 16384
DEPTH = 2

GRID_W = 64
CTX_LEN = 256
N_EVEN = (DEPTH + 1) // 2
N_ODD = DEPTH // 2
S5_WIDTH = D_MODEL // 2
S5_H = 16
S5_GROUPS = S5_WIDTH // S5_H
S5_P = 64
CONV_WIDTH = D_MODEL - S5_WIDTH
CONV_K = 31
IN_EVEN = S5_WIDTH + 2 * CONV_WIDTH
POOL_WINDOWS = (2, 4, 8, 16)
POOL_GROUPS = len(POOL_WINDOWS)
POOL_CH = D_MODEL // POOL_GROUPS
D_FF = 4 * D_MODEL
N_MOD = 6
EPS = 1e-6
DT_MIN = 1e-3
DT_MAX = 1e-1
LAMBDA_RE_MAX = -1e-4

kernel_name = 'hybrid_s5_conformer_pool_dit'


def rms_norm(x, g):
    xf = x.astype(jnp.float32)
    y = xf * lax.rsqrt(jnp.mean(xf * xf, axis=-1, keepdims=True) + EPS)
    return (y * g.astype(jnp.float32)).astype(x.dtype)


def layer_norm(x, g, b):
    xf = x.astype(jnp.float32)
    xc = xf - jnp.mean(xf, axis=-1, keepdims=True)
    var = jnp.mean(xc * xc, axis=-1, keepdims=True)
    y = xc * lax.rsqrt(var + EPS) * g.astype(jnp.float32) + b.astype(jnp.float32)
    return y.astype(x.dtype)


def modulate(h, shift, scale):
    return h * (1 + scale[:, None]) + shift[:, None]


def ada_mod(cvec, w, b, dtype):
    m = jax.nn.silu(cvec.astype(jnp.float32)) @ w.astype(jnp.float32) + b.astype(jnp.float32)
    return jnp.split(m.astype(dtype), N_MOD, axis=-1)


def grid_pos_embed(rows, dtype):
    row = jnp.repeat(jnp.arange(rows, dtype=jnp.float32), GRID_W)
    col = jnp.tile(jnp.arange(GRID_W, dtype=jnp.float32), rows)
    quarter = D_MODEL // 4
    omega = 1.0 / (10000.0 ** (jnp.arange(quarter, dtype=jnp.float32) / quarter))
    def emb(pos):
        ang = pos[:, None] * omega[None, :]
        return jnp.concatenate([jnp.sin(ang), jnp.cos(ang)], axis=-1)
    return jnp.concatenate([emb(row), emb(col)], axis=-1).astype(dtype)


def s5_discretize(lam_re, lam_im, log_step, b_re, b_im, c_re, c_im):
    lam = lax.complex(jnp.minimum(lam_re.astype(jnp.float32), LAMBDA_RE_MAX), lam_im.astype(jnp.float32))
    dt = jnp.exp(log_step.astype(jnp.float32))[:, None]
    lam_bar = jnp.exp(lam * dt)
    b = lax.complex(b_re.astype(jnp.float32), b_im.astype(jnp.float32))
    b_bar = ((lam_bar - 1.0) / lam)[..., None] * b
    cm = lax.complex(c_re.astype(jnp.float32), c_im.astype(jnp.float32))
    return lam_bar, b_bar, cm


def _ssm_combine(left, right):
    a_l, b_l = left
    a_r, b_r = right
    return a_r * a_l, a_r * b_l + b_r


def s5_scan(ug, lam_bar, b_bar, cm, s0):
    bu = jnp.einsum('blgh,gph->blgp', ug.astype(jnp.complex64), b_bar)
    bu = bu.at[:, 0].add(lam_bar[None] * s0)
    a = jnp.broadcast_to(lam_bar, bu.shape)
    _, states = lax.associative_scan(_ssm_combine, (a, bu), axis=1)
    y = jnp.einsum('blgp,ghp->blgh', states, cm).real
    return y, states[:, -1]


def even_mixer(h, ep, s0_f, s0_b):
    (w_in, w_out, lam_re, lam_im, log_step, b_re, b_im, c_re, c_im,
     d_skip, w_glu, conv_w, conv_b, ln_g, ln_b) = ep
    bsz, length, _ = h.shape
    z = h @ w_in
    u = z[..., :S5_WIDTH]
    v = z[..., S5_WIDTH:S5_WIDTH + CONV_WIDTH]
    gt = z[..., S5_WIDTH + CONV_WIDTH:]
    uf = u.astype(jnp.float32)
    ug = uf.reshape(bsz, length, S5_GROUPS, S5_H)
    lb_f, bb_f, cm_f = s5_discretize(lam_re[0], lam_im[0], log_step[0], b_re[0], b_im[0], c_re[0], c_im[0])
    lb_b, bb_b, cm_b = s5_discretize(lam_re[1], lam_im[1], log_step[1], b_re[1], b_im[1], c_re[1], c_im[1])
    y_f, s_f = s5_scan(ug, lb_f, bb_f, cm_f, s0_f)
    y_b, s_b = s5_scan(jnp.flip(ug, axis=1), lb_b, bb_b, cm_b, s0_b)
    ya = (y_f + jnp.flip(y_b, axis=1)).reshape(bsz, length, S5_WIDTH) + d_skip.astype(jnp.float32) * uf
    ya = jax.nn.gelu(ya)
    ya = ya * jax.nn.sigmoid(ya @ w_glu.astype(jnp.float32))
    vb = v * jax.nn.sigmoid(gt)
    vb = lax.conv_general_dilated(vb, conv_w.astype(vb.dtype)[:, None, :], window_strides=(1,),
                                  padding=[(CONV_K // 2, CONV_K // 2)],
                                  dimension_numbers=('NWC', 'WIO', 'NWC'),
                                  feature_group_count=CONV_WIDTH) + conv_b
    vb = jax.nn.silu(layer_norm(vb, ln_g, ln_b))
    y = jnp.concatenate([ya.astype(h.dtype), vb], axis=-1) @ w_out
    return y, s_f, s_b


def centred_mean_minus_self(xg, win):
    bsz, length, ch = xg.shape
    left = win // 2
    right = win - 1 - left
    cs = jnp.concatenate([jnp.zeros((bsz, 1, ch), xg.dtype), jnp.cumsum(xg, axis=1)], axis=1)
    t = jnp.arange(length)
    lo = jnp.maximum(t - left, 0)
    hi = jnp.minimum(t + right, length - 1)
    s = jnp.take(cs, hi + 1, axis=1) - jnp.take(cs, lo, axis=1)
    cnt = (hi - lo + 1).astype(jnp.float32)[None, :, None]
    return s / cnt - xg


def pool_mixer(h, pool_w, pool_b, pool_scale):
    hf = h.astype(jnp.float32)
    outs = []
    for gi, win in enumerate(POOL_WINDOWS):
        hg = hf[..., gi * POOL_CH:(gi + 1) * POOL_CH]
        pg = centred_mean_minus_self(hg, win)
        outs.append(pg @ pool_w[gi].astype(jnp.float32) + pool_b[gi].astype(jnp.float32))
    y = jnp.concatenate(outs, axis=-1) * pool_scale.astype(jnp.float32)
    return y.astype(h.dtype)


def sq_relu_mlp(h, w1, w2):
    return jnp.square(jax.nn.relu(h @ w1)) @ w2


def setup_inputs(seed: int = 0) -> dict:
    key = jax.random.key(seed)
    ks = jax.random.split(key, 32)
    f32 = jnp.float32
    def nrm(k, shape, s):
        return jax.random.normal(k, shape, f32) * s
    n_idx = jnp.arange(S5_P, dtype=f32)
    return {
        'x': nrm(ks[0], (BATCH, SEQ, D_MODEL), 1.0),
        'c': nrm(ks[1], (BATCH, D_MODEL), 1.0),
        'ctx': nrm(ks[2], (BATCH, CTX_LEN, D_MODEL), 1.0),
        'c_ctx': nrm(ks[3], (D_MODEL,), 1.0),
        'w_ada': nrm(ks[4], (DEPTH, D_MODEL, N_MOD * D_MODEL), 0.5 * D_MODEL ** -0.5),
        'b_ada': nrm(ks[5], (DEPTH, N_MOD * D_MODEL), 0.02),
        'norm_mix_g': 1.0 + nrm(ks[6], (DEPTH, D_MODEL), 0.02),
        'norm_mlp_g': 1.0 + nrm(ks[7], (DEPTH, D_MODEL), 0.02),
        'w_in': nrm(ks[8], (N_EVEN, D_MODEL, IN_EVEN), D_MODEL ** -0.5),
        'w_out': nrm(ks[9], (N_EVEN, D_MODEL, D_MODEL), D_MODEL ** -0.5),
        's5_lam_re': -0.5 + nrm(ks[10], (N_EVEN, 2, S5_GROUPS, S5_P), 0.01),
        's5_lam_im': math.pi * n_idx + nrm(ks[11], (N_EVEN, 2, S5_GROUPS, S5_P), 0.01),
        's5_log_step': jax.random.uniform(ks[12], (N_EVEN, 2, S5_GROUPS), f32,
                                          minval=math.log(DT_MIN), maxval=math.log(DT_MAX)),
        's5_b_re': nrm(ks[13], (N_EVEN, 2, S5_GROUPS, S5_P, S5_H), (2 * S5_H) ** -0.5),
        's5_b_im': nrm(ks[14], (N_EVEN, 2, S5_GROUPS, S5_P, S5_H), (2 * S5_H) ** -0.5),
        's5_c_re': nrm(ks[15], (N_EVEN, 2, S5_GROUPS, S5_H, S5_P), S5_P ** -0.5),
        's5_c_im': nrm(ks[16], (N_EVEN, 2, S5_GROUPS, S5_H, S5_P), S5_P ** -0.5),
        's5_d': nrm(ks[17], (N_EVEN, S5_WIDTH), 0.5),
        's5_w_glu': nrm(ks[18], (N_EVEN, S5_WIDTH, S5_WIDTH), S5_WIDTH ** -0.5),
        'conv_w': nrm(ks[19], (N_EVEN, CONV_K, CONV_WIDTH), CONV_K ** -0.5),
        'conv_b': nrm(ks[20], (N_EVEN, CONV_WIDTH), 0.02),
        'conv_ln_g': 1.0 + nrm(ks[21], (N_EVEN, CONV_WIDTH), 0.02),
        'conv_ln_b': nrm(ks[22], (N_EVEN, CONV_WIDTH), 0.02),
        'pool_w': nrm(ks[23], (N_ODD, POOL_GROUPS, POOL_CH, POOL_CH), POOL_CH ** -0.5),
        'pool_b': nrm(ks[24], (N_ODD, POOL_GROUPS, POOL_CH), 0.02),
        'pool_scale': 1.0 + nrm(ks[25], (N_ODD, D_MODEL), 0.1),
        'mlp_w1': nrm(ks[26], (DEPTH, D_MODEL, D_FF), D_MODEL ** -0.5),
        'mlp_w2': nrm(ks[27], (DEPTH, D_FF, D_MODEL), D_FF ** -0.5),
        'final_g': 1.0 + nrm(ks[28], (D_MODEL,), 0.02),
    }


def reference(x, c, ctx, c_ctx, w_ada, b_ada, norm_mix_g, norm_mlp_g, w_in, w_out,
              s5_lam_re, s5_lam_im, s5_log_step, s5_b_re, s5_b_im, s5_c_re, s5_c_im,
              s5_d, s5_w_glu, conv_w, conv_b, conv_ln_g, conv_ln_b,
              pool_w, pool_b, pool_scale, mlp_w1, mlp_w2, final_g):
    bsz, length, _ = x.shape
    ROWS = length // GRID_W
    h = x + grid_pos_embed(ROWS, x.dtype)[None]
    hc = ctx
    for i in range(DEPTH):
        j = i // 2
        ctx_next = i < DEPTH - 1
        sh1, sc1, g1, sh2, sc2, g2 = ada_mod(c, w_ada[i], b_ada[i], h.dtype)
        n_x = modulate(rms_norm(h, norm_mix_g[i]), sh1, sc1)
        if i % 2 == 0 or ctx_next:
            csh1, csc1, cg1, csh2, csc2, cg2 = ada_mod(c_ctx[None], w_ada[i], b_ada[i], hc.dtype)
            n_c = modulate(rms_norm(hc, norm_mix_g[i]), csh1, csc1)
        if i % 2 == 0:
            ep = (w_in[j], w_out[j], s5_lam_re[j], s5_lam_im[j], s5_log_step[j],
                  s5_b_re[j], s5_b_im[j], s5_c_re[j], s5_c_im[j], s5_d[j], s5_w_glu[j],
                  conv_w[j], conv_b[j], conv_ln_g[j], conv_ln_b[j])
            zeros = jnp.zeros((hc.shape[0], S5_GROUPS, S5_P), jnp.complex64)
            y_c, s_f, s_b = even_mixer(n_c, ep, zeros, zeros)
            y_x, _, _ = even_mixer(n_x, ep, s_f, s_b)
        else:
            y_x = pool_mixer(n_x, pool_w[j], pool_b[j], pool_scale[j])
            if ctx_next:
                y_c = pool_mixer(n_c, pool_w[j], pool_b[j], pool_scale[j])
        h = h + g1[:, None] * y_x
        h = h + g2[:, None] * sq_relu_mlp(modulate(rms_norm(h, norm_mlp_g[i]), sh2, sc2), mlp_w1[i], mlp_w2[i])
        if ctx_next:
            hc = hc + cg1[:, None] * y_c
            hc = hc + cg2[:, None] * sq_relu_mlp(modulate(rms_norm(hc, norm_mlp_g[i]), csh2, csc2), mlp_w1[i], mlp_w2[i])
    return rms_norm(h, final_g)
```

```cpp
#include <hip/hip_runtime.h>
#include <hip/hip_cooperative_groups.h>
#include <cstdio>
namespace cg = cooperative_groups;

#define LAS __attribute__((address_space(3)))
typedef unsigned short bf16_t;
typedef short bf16x8 __attribute__((ext_vector_type(8)));
typedef float f32x4 __attribute__((ext_vector_type(4)));
typedef float f32x2 __attribute__((ext_vector_type(2)));
typedef unsigned u32x4 __attribute__((ext_vector_type(4)));
typedef unsigned u32x2 __attribute__((ext_vector_type(2)));

constexpr int L = 16384, D = 1024, NCTX = 256, MROWS = L + NCTX, DFF = 4096;
constexpr int TCH = 32;
constexpr int NCH = L / TCH;
constexpr int UGR = 768, UGK = 768;
constexpr int NTHR = 512, NWAVES = 8;
constexpr int LDS_BYTES = 136 * 1024;
constexpr int XCD_BAR_WORDS_C = 3456;
constexpr int LDS_BARST_OFF = LDS_BYTES - 16;

constexpr size_t WS_WIN = 0;
constexpr size_t WS_WOUT = WS_WIN + (size_t)1536 * 1024 * 2;
constexpr size_t WS_WGLU = WS_WOUT + (size_t)1024 * 1024 * 2;
constexpr size_t WS_W1 = WS_WGLU + (size_t)512 * 512 * 2;
constexpr size_t WS_W2 = WS_W1 + (size_t)2 * 4096 * 1024 * 2;
constexpr size_t WS_WPOOL = WS_W2 + (size_t)2 * 4096 * 1024 * 2;
constexpr size_t WS_MOD = WS_WPOOL + (size_t)4 * 256 * 256 * 2;
constexpr size_t WS_PR = WS_MOD + (size_t)3 * 6144 * 4;
constexpr size_t WS_PC = WS_PR + (size_t)256 * 512 * 4;
constexpr size_t WS_LAMT = WS_PC + (size_t)64 * 512 * 4;
constexpr size_t WS_LPG = WS_LAMT + (size_t)64 * 64 * 8;
constexpr size_t WS_BBG = WS_LPG + (size_t)64 * 33 * 64 * 8;
constexpr size_t WS_KTG = WS_BBG + (size_t)64 * 64 * 16 * 8;
constexpr size_t WS_BAR = WS_KTG + (size_t)64 * 32 * 256 * 4;
constexpr size_t WS_BUFA = WS_BAR + (size_t)XCD_BAR_WORDS_C * 4;
constexpr size_t WS_SLOC = WS_BUFA + (size_t)MROWS * 1024 * 2;
constexpr size_t WS_BIG = WS_SLOC + (size_t)32 * UGR * 256 * 4;
constexpr size_t WS_HD = WS_BIG;
constexpr size_t WS_UG = WS_BIG;
constexpr size_t WS_ZVG = WS_UG + (size_t)32 * UGR * UGK * 2;
constexpr size_t WS_YA = WS_ZVG + (size_t)L * 1024 * 2;
constexpr size_t WS_MMAT = WS_YA + (size_t)L * 512 * 2;
constexpr size_t WS_HMAT = WS_MMAT + (size_t)32 * 512 * 768 * 2;
constexpr size_t WS_BIG_END_A = WS_HMAT + (size_t)32 * 256 * 512 * 2;
constexpr size_t WS_END = WS_BIG + (size_t)L * DFF * 2;
static_assert(WS_BIG_END_A <= WS_END, "alias region overflow");
static_assert(WS_END <= (size_t)256 * 1024 * 1024, "workspace too large");

__device__ __forceinline__ unsigned cvt_pk_bf16(float lo, float hi) { unsigned r; asm("v_cvt_pk_bf16_f32 %0, %1, %2" : "=v"(r) : "v"(lo), "v"(hi)); return r; }
__device__ __forceinline__ float bf_lo(unsigned w) { return __uint_as_float(w << 16); }
__device__ __forceinline__ float bf_hi(unsigned w) { return __uint_as_float(w & 0xffff0000u); }
__device__ __forceinline__ float wave_sum(float v) {
#pragma unroll
    for (int o = 1; o < 64; o <<= 1) v += __shfl_xor(v, o);
    return v;
}
__device__ __forceinline__ float sigmoidf_(float x) { return __builtin_amdgcn_rcpf(1.0f + __builtin_amdgcn_exp2f(-1.4426950408889634f * x)); }
__device__ __forceinline__ float gelu_tanh(float x) { const float z = 0.7978845608028654f * (x + 0.044715f * x * x * x); return x * __builtin_amdgcn_rcpf(1.0f + __builtin_amdgcn_exp2f(-2.8853900817779268f * z)); }

constexpr int BM = 256, BK = 64, HALF = 128, HTB = HALF * BK * 2, STAGE_BYTES = 8 * HTB, NXCD = 8, WGM = 8;
__device__ __forceinline__ int lds_byte(int r, int c) { const int st = (r >> 4) * 2 + (c >> 5), rr = r & 15, cc = c & 31, ob = rr * 64 + cc * 2; return st * 1024 + (ob ^ (((ob >> 9) & 1) << 5)); }
__device__ __forceinline__ void stage_rc(int b, int& R, int& C) { const int st = b / 1024, sb = b % 1024, swz = sb ^ (((sb >> 9) & 1) << 5); R = (st >> 1) * 16 + swz / 64; C = (st & 1) * 32 + (swz % 64) / 2; }
__device__ __forceinline__ int perm32(int rho) { const int n = rho >> 4, i = rho & 15; return 8 * (i >> 2) + 4 * n + (i & 3); }

struct Unit { int pm, pn, g; };
struct GemmD { const bf16_t* A; const bf16_t* Bt; int lda, ldb, K, pad; size_t sA, sB; };
struct Sched {
    int nM, nN, nB, G, c;
    __device__ __forceinline__ bool next(int i, Unit& u) const {
        const int per = nM * nN, nwg = per * nB;
        const long Lq = (long)i * G + c; if (Lq >= nwg) return false;
        if (nB == 1) {
            int wgid = (int)Lq; { const int q = nwg / NXCD, r = nwg % NXCD, xcd = wgid % NXCD, off = wgid / NXCD; wgid = (xcd < r ? xcd * (q + 1) : r * (q + 1) + (xcd - r) * q) + off; }
            const int nig = WGM * nN, gid = wgid / nig, fm = gid * WGM, gsz = (nM - fm) < WGM ? (nM - fm) : WGM;
            u.pm = fm + ((wgid % nig) % gsz); u.pn = (wgid % nig) / gsz; u.g = 0;
        } else { const int q = (int)Lq; u.g = q / per; const int r = q % per; u.pm = r / nN; u.pn = r % nN; }
        return true;
    }
};

template <class Epi>
__device__ __forceinline__ void gemm_phase(LAS unsigned char* lds, const GemmD g, const Sched& S, const Epi& E) {
    int tid = threadIdx.x; asm volatile("" : "+v"(tid));
    const int wid = __builtin_amdgcn_readfirstlane(tid >> 6), lane = tid & 63, wr = wid >> 2, wc = wid & 3, fr = lane & 15, fq = lane >> 4;
    int K = g.K; asm volatile("" : "+s"(K));
    const int nt = K / BK;
    unsigned voffA[2], voffB[2];
#pragma unroll
    for (int i = 0; i < 2; ++i) { int R, C; stage_rc(tid * 16 + i * 8192, R, C); const int Rb = Epi::PERM ? ((R & ~31) + perm32(R & 31)) : R;
        voffA[i] = (unsigned)(R * g.lda + C) * 2u; voffB[i] = (unsigned)(Rb * g.ldb + C) * 2u; }
    const size_t kstep = (size_t)(BK * 2);
    const size_t hstepA = (size_t)HALF * g.lda * 2, hstepB = (size_t)HALF * g.ldb * 2;
    const size_t tstepA = 2 * hstepA, tstepB = 2 * hstepB;
    const unsigned ldsw = (unsigned)wid * 1024u;
    const int aoff = lds_byte(wr * 64 + fr, fq * 8), boff = lds_byte(wc * 32 + fr, fq * 8);
#define PG8_SA(b, h) (((b) * 2 + (h)) * HTB)
#define PG8_SB(b, h) ((4 + (b) * 2 + (h)) * HTB)
#define PG8_STAGE(bufoff, gbase, voff) do { _Pragma("unroll") for (int _i = 0; _i < 2; ++_i) \
        __builtin_amdgcn_global_load_lds((const unsigned*)((const char*)(gbase) + (voff)[_i]), (LAS unsigned*)(lds + (bufoff) + ldsw + _i * 8192), 16, 0, 0); } while (0)
#define PG8_LDA(dst, b, h) do { _Pragma("unroll") for (int m = 0; m < 4; ++m) _Pragma("unroll") for (int k = 0; k < 2; ++k) dst[m][k] = *(const LAS bf16x8*)(lds + PG8_SA(b, h) + aoff + m * 2048 + k * 1024); } while (0)
#define PG8_LDB(dst, b, h) do { _Pragma("unroll") for (int n = 0; n < 2; ++n) _Pragma("unroll") for (int k = 0; k < 2; ++k) dst[n][k] = *(const LAS bf16x8*)(lds + PG8_SB(b, h) + boff + n * 2048 + k * 1024); } while (0)
#define PG8_MMA(ai, bj, At, Bt) do { __builtin_amdgcn_s_setprio(1); _Pragma("unroll") for (int m = 0; m < 4; ++m) _Pragma("unroll") for (int n = 0; n < 2; ++n) _Pragma("unroll") for (int k = 0; k < 2; ++k) \
        acc[ai][bj][m][n] = __builtin_amdgcn_mfma_f32_16x16x32_bf16(Bt[n][k], At[m][k], acc[ai][bj][m][n], 0, 0, 0); __builtin_amdgcn_s_setprio(0); } while (0)
#define PG8_WAIT_V(n) asm volatile("s_waitcnt vmcnt(" #n ")" ::: "memory")
#define PG8_WAIT_L(n) asm volatile("s_waitcnt lgkmcnt(" #n ")" ::: "memory")
#define PG8_BAR __builtin_amdgcn_s_barrier()
#define PG8_SCHED __builtin_amdgcn_sched_barrier(0)
    Unit cur, nxt; int ui = 0;
    if (!S.next(0, cur)) return;
    f32x4 acc[2][2][4][2];
#pragma unroll
    for (int a = 0; a < 2; ++a)
#pragma unroll
        for (int b = 0; b < 2; ++b)
#pragma unroll
            for (int m = 0; m < 4; ++m)
#pragma unroll
                for (int n = 0; n < 2; ++n) acc[a][b][m][n] = (f32x4){0.f, 0.f, 0.f, 0.f};
    bf16x8 At[4][2], B0[2][2], B1[2][2];
    const char* cA = (const char*)g.A + (size_t)cur.g * g.sA * 2 + (size_t)cur.pm * tstepA; const char* cB = (const char*)g.Bt + (size_t)cur.g * g.sB * 2 + (size_t)cur.pn * tstepB;
    PG8_STAGE(PG8_SB(0, 0), cB, voffB); PG8_STAGE(PG8_SA(0, 0), cA, voffA); PG8_STAGE(PG8_SB(0, 1), cB + hstepB, voffB); PG8_STAGE(PG8_SA(0, 1), cA + hstepA, voffA);
    if (wr == 1) PG8_BAR;
    PG8_WAIT_V(4); PG8_BAR;
    PG8_STAGE(PG8_SB(1, 0), cB + kstep, voffB); PG8_STAGE(PG8_SA(1, 0), cA + kstep, voffA); PG8_STAGE(PG8_SB(1, 1), cB + hstepB + kstep, voffB);
    PG8_WAIT_V(6); PG8_BAR;
    for (;;) {
        const bool has_next = S.next(ui + 1, nxt);
        const char* nA = has_next ? (const char*)g.A + (size_t)nxt.g * g.sA * 2 + (size_t)nxt.pm * tstepA : cA;
        const char* nB = has_next ? (const char*)g.Bt + (size_t)nxt.g * g.sB * 2 + (size_t)nxt.pn * tstepB : cB;
        for (int t = 0; t < nt; t += 2) {
            const bool last = (t == nt - 2);
            const char* a1 = cA + (size_t)(t + 1) * kstep;
            const char* a2 = last ? nA : cA + (size_t)(t + 2) * kstep; const char* b2 = last ? nB : cB + (size_t)(t + 2) * kstep;
            const char* a3 = a2 + kstep; const char* b3 = b2 + kstep;
            PG8_LDB(B0, 0, 0); PG8_SCHED; PG8_LDA(At, 0, 0); PG8_STAGE(PG8_SA(1, 1), a1 + hstepA, voffA);
            PG8_WAIT_L(8); PG8_BAR; PG8_WAIT_L(0); PG8_MMA(0, 0, At, B0); PG8_BAR; PG8_SCHED;
            PG8_LDB(B1, 0, 1); PG8_STAGE(PG8_SB(0, 0), b2, voffB);
            PG8_BAR; PG8_WAIT_L(0); PG8_MMA(0, 1, At, B1); PG8_BAR;
            PG8_LDA(At, 0, 1); PG8_STAGE(PG8_SA(0, 0), a2, voffA);
            PG8_BAR; PG8_WAIT_L(0); PG8_MMA(1, 0, At, B0); PG8_BAR; PG8_SCHED;
            PG8_STAGE(PG8_SB(0, 1), b2 + hstepB, voffB);
            PG8_WAIT_V(6); PG8_BAR; PG8_MMA(1, 1, At, B1); PG8_BAR;
            PG8_LDB(B0, 1, 0); PG8_SCHED; PG8_LDA(At, 1, 0); PG8_STAGE(PG8_SA(0, 1), a2 + hstepA, voffA);
            PG8_WAIT_L(8); PG8_BAR; PG8_WAIT_L(0); PG8_MMA(0, 0, At, B0); PG8_BAR; PG8_SCHED;
            PG8_LDB(B1, 1, 1); PG8_STAGE(PG8_SB(1, 0), b3, voffB);
            PG8_BAR; PG8_WAIT_L(0); PG8_MMA(0, 1, At, B1); PG8_BAR;
            PG8_LDA(At, 1, 1); PG8_STAGE(PG8_SA(1, 0), a3, voffA);
            PG8_BAR; PG8_WAIT_L(0); PG8_MMA(1, 0, At, B0); PG8_BAR; PG8_SCHED;
            PG8_STAGE(PG8_SB(1, 1), b3 + hstepB, voffB);
            PG8_WAIT_V(6); PG8_BAR; PG8_MMA(1, 1, At, B1); PG8_BAR;
        }
        E(acc, cur, wr, wc, fr, fq);
        if (!has_next) break;
#pragma unroll
        for (int a = 0; a < 2; ++a)
#pragma unroll
            for (int b = 0; b < 2; ++b)
#pragma unroll
                for (int m = 0; m < 4; ++m)
#pragma unroll
                    for (int n = 0; n < 2; ++n) acc[a][b][m][n] = (f32x4){0.f, 0.f, 0.f, 0.f};
        cur = nxt; cA = nA; cB = nB; ++ui;
    }
    PG8_WAIT_V(0);
    if (wr == 0) PG8_BAR;
    PG8_BAR;
#undef PG8_SA
#undef PG8_SB
#undef PG8_STAGE
#undef PG8_LDA
#undef PG8_LDB
#undef PG8_MMA
#undef PG8_WAIT_V
#undef PG8_WAIT_L
#undef PG8_BAR
#undef PG8_SCHED
}

#define EPI_ROWS_BEGIN  _Pragma("unroll") for (int ai = 0; ai < 2; ++ai) _Pragma("unroll") for (int m = 0; m < 4; ++m) { const int row = row0 + ai * HALF + m * 16;
#define EPI_ROWS_END asm volatile("" ::: "memory"); }
typedef const f32x4 (&AccRef)[2][2][4][2];

struct EpiWin {
    static constexpr bool PERM = true; bf16_t* UG; bf16_t* ZVG;
    __device__ __forceinline__ void operator()(AccRef acc, const Unit& u, int wr, int wc, int fr, int fq) const {
        const int row0 = u.pm * BM + wr * 64 + fr, colb = u.pn * BM + wc * 32 + 8 * fq;
        EPI_ROWS_BEGIN
#pragma unroll
            for (int bj = 0; bj < 2; ++bj) { const int col = colb + bj * HALF; const f32x4 v0 = acc[ai][bj][m][0], v1 = acc[ai][bj][m][1];
                u32x4 w; w.x = cvt_pk_bf16(v0[0], v0[1]); w.y = cvt_pk_bf16(v0[2], v0[3]); w.z = cvt_pk_bf16(v1[0], v1[1]); w.w = cvt_pk_bf16(v1[2], v1[3]);
                if (col < 512) { const int chunk = row >> 5, tau = row & 31, gg = col >> 4, h0 = col & 15;
                    *(u32x4*)(UG + ((size_t)(gg * UGR + chunk) * UGK + tau * 16 + h0)) = w; }
                else if (row < L) { *(u32x4*)(ZVG + (size_t)row * 1024 + (col - 512)) = w; } }
        EPI_ROWS_END
    }
};
struct EpiF32Store {
    static constexpr bool PERM = false; float* C; int ldc; size_t sC;
    __device__ __forceinline__ void operator()(AccRef acc, const Unit& u, int wr, int wc, int fr, int fq) const {
        const int row0 = u.pm * BM + wr * 64 + fr, col0 = u.pn * BM + wc * 32 + 4 * fq; float* Cb = C + (size_t)u.g * sC;
        EPI_ROWS_BEGIN
#pragma unroll
            for (int bj = 0; bj < 2; ++bj)
#pragma unroll
                for (int n = 0; n < 2; ++n) *(f32x4*)(Cb + (size_t)row * ldc + col0 + bj * HALF + n * 16) = acc[ai][bj][m][n];
        EPI_ROWS_END
    }
};
struct EpiY {
    static constexpr bool PERM = true; bf16_t* YA;
    __device__ __forceinline__ void operator()(AccRef acc, const Unit& u, int wr, int wc, int fr, int fq) const {
        const int row0 = u.pm * BM + wr * 64 + fr, colb = u.pn * BM + wc * 32 + 8 * fq;
        EPI_ROWS_BEGIN
#pragma unroll
            for (int bj = 0; bj < 2; ++bj) { const int col = colb + bj * HALF; const f32x4 v0 = acc[ai][bj][m][0], v1 = acc[ai][bj][m][1];
                u32x4 w; w.x = cvt_pk_bf16(gelu_tanh(v0[0]), gelu_tanh(v0[1])); w.y = cvt_pk_bf16(gelu_tanh(v0[2]), gelu_tanh(v0[3]));
                w.z = cvt_pk_bf16(gelu_tanh(v1[0]), gelu_tanh(v1[1])); w.w = cvt_pk_bf16(gelu_tanh(v1[2]), gelu_tanh(v1[3]));
                const int tau = col >> 4, h0 = col & 15; const size_t t = (size_t)row * TCH + tau;
                *(u32x4*)(YA + t * 512 + u.g * 16 + h0) = w; }
        EPI_ROWS_END
    }
};
struct EpiGlu {
    static constexpr bool PERM = true; const bf16_t* YA; bf16_t* A1;
    __device__ __forceinline__ void operator()(AccRef acc, const Unit& u, int wr, int wc, int fr, int fq) const {
        const int row0 = u.pm * BM + wr * 64 + fr, colb = u.pn * BM + wc * 32 + 8 * fq;
        EPI_ROWS_BEGIN
#pragma unroll
            for (int bj = 0; bj < 2; ++bj) { const int col = colb + bj * HALF; const f32x4 v0 = acc[ai][bj][m][0], v1 = acc[ai][bj][m][1];
                const u32x4 y = *(const u32x4*)(YA + (size_t)row * 512 + col);
                u32x4 w; w.x = cvt_pk_bf16(bf_lo(y.x) * sigmoidf_(v0[0]), bf_hi(y.x) * sigmoidf_(v0[1])); w.y = cvt_pk_bf16(bf_lo(y.y) * sigmoidf_(v0[2]), bf_hi(y.y) * sigmoidf_(v0[3]));
                w.z = cvt_pk_bf16(bf_lo(y.z) * sigmoidf_(v1[0]), bf_hi(y.z) * sigmoidf_(v1[1])); w.w = cvt_pk_bf16(bf_lo(y.w) * sigmoidf_(v1[2]), bf_hi(y.w) * sigmoidf_(v1[3]));
                *(u32x4*)(A1 + (size_t)row * 1024 + col) = w; }
        EPI_ROWS_END
    }
};
struct EpiWout {
    static constexpr bool PERM = false; const float* x; const float* PR; const float* PC; const float* g1; float* H;
    __device__ __forceinline__ void operator()(AccRef acc, const Unit& u, int wr, int wc, int fr, int fq) const {
        const int row0 = u.pm * BM + wr * 64 + fr, col0 = u.pn * BM + wc * 32 + 4 * fq;
        EPI_ROWS_BEGIN
#pragma unroll
            for (int bj = 0; bj < 2; ++bj)
#pragma unroll
                for (int n = 0; n < 2; ++n) { const int col = col0 + bj * HALF + n * 16;
                    const f32x4 xv = *(const f32x4*)(x + (size_t)row * D + col);
                    const f32x4 pv = col < 512 ? *(const f32x4*)(PR + (size_t)(row >> 6) * 512 + col) : *(const f32x4*)(PC + (size_t)(row & 63) * 512 + (col - 512));
                    const f32x4 gv = *(const f32x4*)(g1 + col);
                    *(f32x4*)(H + (size_t)row * D + col) = xv + pv + gv * acc[ai][bj][m][n]; }
        EPI_ROWS_END
    }
};
struct EpiMlp1 {
    static constexpr bool PERM = true; bf16_t* HD;
    __device__ __forceinline__ void operator()(AccRef acc, const Unit& u, int wr, int wc, int fr, int fq) const {
        const int row0 = u.pm * BM + wr * 64 + fr, colb = u.pn * BM + wc * 32 + 8 * fq;
        EPI_ROWS_BEGIN
#pragma unroll
            for (int bj = 0; bj < 2; ++bj) { const int col = colb + bj * HALF; f32x4 v0 = acc[ai][bj][m][0], v1 = acc[ai][bj][m][1];
#pragma unroll
                for (int j = 0; j < 4; ++j) { const float a = fmaxf(v0[j], 0.f), b = fmaxf(v1[j], 0.f); v0[j] = a * a; v1[j] = b * b; }
                u32x4 w; w.x = cvt_pk_bf16(v0[0], v0[1]); w.y = cvt_pk_bf16(v0[2], v0[3]); w.z = cvt_pk_bf16(v1[0], v1[1]); w.w = cvt_pk_bf16(v1[2], v1[3]);
                *(u32x4*)(HD + (size_t)row * DFF + col) = w; }
        EPI_ROWS_END
    }
};
struct EpiMlp2 {
    static constexpr bool PERM = false; const float* g2; float* H;
    __device__ __forceinline__ void operator()(AccRef acc, const Unit& u, int wr, int wc, int fr, int fq) const {
        const int row0 = u.pm * BM + wr * 64 + fr, col0 = u.pn * BM + wc * 32 + 4 * fq;
        EPI_ROWS_BEGIN
#pragma unroll
            for (int bj = 0; bj < 2; ++bj)
#pragma unroll
                for (int n = 0; n < 2; ++n) { const int col = col0 + bj * HALF + n * 16; float* hp = H + (size_t)row * D + col;
                    const f32x4 gv = *(const f32x4*)(g2 + col); *(f32x4*)hp = *(const f32x4*)hp + gv * acc[ai][bj][m][n]; }
        EPI_ROWS_END
    }
};
struct EpiPool {
    static constexpr bool PERM = false; const float* g1; const float* pb; const float* ps; float* H;
    __device__ __forceinline__ void operator()(AccRef acc, const Unit& u, int wr, int wc, int fr, int fq) const {
        const int row0 = u.pm * BM + wr * 64 + fr, col0 = u.g * 256 + wc * 32 + 4 * fq;
        EPI_ROWS_BEGIN
#pragma unroll
            for (int bj = 0; bj < 2; ++bj)
#pragma unroll
                for (int n = 0; n < 2; ++n) { const int col = col0 + bj * HALF + n * 16; float* hp = H + (size_t)row * D + col;
                    const f32x4 gv = *(const f32x4*)(g1 + col), bv = *(const f32x4*)(pb + col), sv = *(const f32x4*)(ps + col);
                    *(f32x4*)hp = *(const f32x4*)hp + gv * ((acc[ai][bj][m][n] + bv) * sv); }
        EPI_ROWS_END
    }
};


#define XB_TMO      128
#define XB_XCNT(j)  (256  + 64 * (j))
#define XB_XSUB(j)  (1280 + 64 * (j))
#define XB_XGEN(j)  (2304 + 64 * (j))
#define XB_TOP      3328
#define XB_TOPGEN   3392
#define XCD_BAR_WORDS 3456
#define XB_SPIN_CAP (1u << 22)
__device__ __forceinline__ unsigned xb_ld(unsigned* p)              { return __hip_atomic_load(p, __ATOMIC_RELAXED, __HIP_MEMORY_SCOPE_AGENT); }
__device__ __forceinline__ unsigned xb_add(unsigned* p, unsigned v) { return __hip_atomic_fetch_add(p, v, __ATOMIC_RELAXED, __HIP_MEMORY_SCOPE_AGENT); }
__device__ __forceinline__ unsigned xb_xcc_id() { return (unsigned)__builtin_amdgcn_s_getreg((3 << 11) | 20) & 0xFu; }
#define XB_SPIN(cond, bar) do { unsigned _sp = 0; while (cond) { __builtin_amdgcn_s_sleep(1); \
    if ((++_sp & 255u) == 0u) { if (xb_ld(&(bar)[XB_TMO])) break; if (_sp > XB_SPIN_CAP) { atomicAdd(&(bar)[XB_TMO], 1u); break; } } } } while (0)
struct XcdBarrier { unsigned* bar; unsigned x; volatile LAS unsigned* st; };
__device__ __forceinline__ XcdBarrier xcd_barrier_post(unsigned* bar, volatile LAS unsigned* st) {
    XcdBarrier b; b.bar = bar; b.x = (unsigned)__builtin_amdgcn_readfirstlane((int)xb_xcc_id()); b.st = st;
    if (threadIdx.x == 0) (void)xb_add(&bar[XB_XCNT(b.x)], 1u);
    return b;
}
__device__ __forceinline__ void xcd_barrier_complete(unsigned* bar, unsigned x, unsigned& nloc, unsigned& nx) {
    const unsigned G = gridDim.x * gridDim.y * gridDim.z;
    unsigned sum, cnt, mine, sp = 0u;
    for (;;) {
        sum = 0u; cnt = 0u; mine = 0u;
#pragma unroll
        for (unsigned j = 0; j < 16; ++j) { const unsigned c = xb_ld(&bar[XB_XCNT(j)]); sum += c; cnt += (c > 0u) ? 1u : 0u; mine = (j == x) ? c : mine; }
        if (sum == G) break;
        __builtin_amdgcn_s_sleep(1);
        if ((++sp & 255u) == 0u) { if (xb_ld(&bar[XB_TMO])) break; if (sp > XB_SPIN_CAP) { atomicAdd(&bar[XB_TMO], 1u); break; } }
    }
    nloc = mine > 0u ? mine : 1u; nx = cnt > 0u ? cnt : 1u;
}
__device__ __forceinline__ void xcd_barrier(const XcdBarrier& b) {
    asm volatile("s_waitcnt vmcnt(0)" ::: "memory");
    __syncthreads();
    if (threadIdx.x == 0) {
        unsigned* bar = b.bar; unsigned bx = b.x; asm volatile("" : "+s"(bar), "+s"(bx));
        __builtin_amdgcn_s_waitcnt(0);
        unsigned nloc = b.st[0], nx = b.st[1];
        if (nloc == 0u) { xcd_barrier_complete(bar, bx, nloc, nx); b.st[0] = nloc; b.st[1] = nx; }
        const unsigned old = xb_add(&bar[XB_XSUB(bx)], 1u);
        const unsigned gen = old / nloc;
        if (old + 1u == (gen + 1u) * nloc) {
            __builtin_amdgcn_fence(__ATOMIC_RELEASE, "agent");
            asm volatile("s_waitcnt vmcnt(0)" ::: "memory");
            const unsigned og = xb_add(&bar[XB_TOP], 1u);
            const unsigned tg = og / nx;
            if (og + 1u == (tg + 1u) * nx) xb_add(&bar[XB_TOPGEN], 1u);
            else XB_SPIN(xb_ld(&bar[XB_TOPGEN]) == tg, bar);
            __builtin_amdgcn_fence(__ATOMIC_ACQUIRE, "agent");
            xb_add(&bar[XB_XGEN(bx)], 1u);
            asm volatile("s_waitcnt vmcnt(0)" ::: "memory");
        } else {
            XB_SPIN(xb_ld(&bar[XB_XGEN(bx)]) == gen, bar);
            __builtin_amdgcn_fence(__ATOMIC_ACQUIRE, "agent");
            asm volatile("s_waitcnt vmcnt(0)" ::: "memory");
        }
    }
    __syncthreads();
}

struct Params {
    const float *x, *c, *ctx, *c_ctx, *w_ada, *b_ada, *norm_mix_g, *norm_mlp_g, *w_in, *w_out;
    const float *lam_re, *lam_im, *log_step, *b_re, *b_im, *c_re, *c_im, *s5_d, *w_glu, *conv_w, *conv_b, *ln_g, *ln_b;
    const float *pool_w, *pool_b, *pool_scale, *mlp_w1, *mlp_w2, *final_g;
    float* out; unsigned char* ws;
    int cg_sync, pad;
};

typedef const Params __attribute__((address_space(4))) CParams;

__device__ __forceinline__ void transpose_item(const float* W, int K, int N, bf16_t* WT, LAS float* scr, int item, int lane) {
    const int nblk = N / 32, kb = item / nblk, nb = item % nblk, k0 = 64 * kb, n0 = 32 * nb;
    float tv[32];
#pragma unroll
    for (int i = 0; i < 32; ++i) { const int kk = 2 * i + (lane >> 5); tv[i] = W[(size_t)(k0 + kk) * N + n0 + (lane & 31)]; }
#pragma unroll
    for (int i = 0; i < 32; ++i) { const int kk = 2 * i + (lane >> 5); scr[kk * 33 + (lane & 31)] = tv[i]; }
    asm volatile("s_waitcnt lgkmcnt(0)" ::: "memory");
    const int c = lane & 7;
#pragma unroll
    for (int j = 0; j < 4; ++j) { const int n = (lane >> 3) + 8 * j; const LAS float* s = scr + (8 * c) * 33 + n;
        u32x4 o; o.x = cvt_pk_bf16(s[0 * 33], s[1 * 33]); o.y = cvt_pk_bf16(s[2 * 33], s[3 * 33]); o.z = cvt_pk_bf16(s[4 * 33], s[5 * 33]); o.w = cvt_pk_bf16(s[6 * 33], s[7 * 33]);
        *(u32x4*)(WT + (size_t)(n0 + n) * K + k0 + 8 * c) = o; }
    asm volatile("s_waitcnt lgkmcnt(0)" ::: "memory");
}

__device__ __forceinline__ void ada_item(CParams& p, LAS unsigned char* lds, int it, int tid, int wave, int lane) {
    LAS float* sc = (LAS float*)lds; LAS float* scc = sc + 1024; LAS float* red = scc + 1024;
    const int l = it / 96, cb = it % 96;
    for (int k = tid; k < 1024; k += NTHR) { const float a = p.c[k], b = p.c_ctx[k]; sc[k] = a / (1.0f + __expf(-a)); scc[k] = b / (1.0f + __expf(-b)); }
    __syncthreads();
    const int col = cb * 64 + lane; const float* W = p.w_ada + (size_t)l * 1024 * 6144 + col;
    float a1 = 0.f, a2 = 0.f; const int k0 = wave * 128;
#pragma unroll 32
    for (int k = 0; k < 128; ++k) { const float w = W[(size_t)(k0 + k) * 6144]; a1 += sc[k0 + k] * w; a2 += scc[k0 + k] * w; }
    red[(wave * 64 + lane) * 2] = a1; red[(wave * 64 + lane) * 2 + 1] = a2;
    __syncthreads();
    if (wave == 0) { float s1 = 0.f, s2 = 0.f;
#pragma unroll
        for (int w = 0; w < 8; ++w) { s1 += red[(w * 64 + lane) * 2]; s2 += red[(w * 64 + lane) * 2 + 1]; }
        const float b = p.b_ada[l * 6144 + col]; float* MOD = (float*)(p.ws + WS_MOD);
        if (l == 0) { MOD[col] = s1 + b; MOD[6144 + col] = s2 + b; } else { MOD[2 * 6144 + col] = s1 + b; } }
    __syncthreads();
}


__device__ __forceinline__ void mlp_transposes(CParams& p, LAS unsigned char* lds, int first, int count, int slot, int nslots, int wave, int lane) {
    LAS float* scr = (LAS float*)(lds + wave * 8704);
    bf16_t* WT_1 = (bf16_t*)(p.ws + WS_W1); bf16_t* WT_2 = (bf16_t*)(p.ws + WS_W2);
    for (int it = first + slot; it < first + count; it += nslots) { const int blk = it >> 11, r = it & 2047, l = blk >> 1;
        if ((blk & 1) == 0) transpose_item(p.mlp_w1 + (size_t)l * 1024 * 4096, 1024, 4096, WT_1 + (size_t)l * 4096 * 1024, scr, r, lane);
        else transpose_item(p.mlp_w2 + (size_t)l * 4096 * 1024, 4096, 1024, WT_2 + (size_t)l * 1024 * 4096, scr, r, lane); }
}
constexpr int LPD = 34;
__device__ __forceinline__ void s5_part(CParams& p, LAS unsigned char* lds, int g, int j, int tid) {
    LAS f32x2* LP = (LAS f32x2*)lds;
    LAS f32x2* BB = LP + 64 * LPD;
    LAS f32x2* CM = BB + 64 * 16;
    const int dir = j >> 2, d0 = 8 * (j & 3);
    f32x2* LPG = (f32x2*)(p.ws + WS_LPG) + (size_t)(g * 2 + dir) * 33 * 64;
    f32x2* BBG = (f32x2*)(p.ws + WS_BBG) + (size_t)(g * 2 + dir) * 64 * 16;
    float* KTG = (float*)(p.ws + WS_KTG) + (size_t)(g * 2 + dir) * 32 * 256;
    const bool pub = (j & 3) == 0;
    const float dtf = __expf(p.log_step[dir * 32 + g]);
    for (int idx = tid; idx < 64 * 33; idx += NTHR) { const int pp = idx & 63, d = idx >> 6; const int gi = (dir * 32 + g) * 64 + pp;
        const float a = fminf(p.lam_re[gi], -1e-4f) * dtf, b = p.lam_im[gi] * dtf;
        float sn, cs; sincosf(b * (float)d, &sn, &cs); const float er = expf(a * (float)d);
        const f32x2 z = (f32x2){er * cs, er * sn}; LP[pp * LPD + d] = z;
        if (pub) { LPG[d * 64 + pp] = z; if (d == 32) ((f32x2*)(p.ws + WS_LAMT))[(g * 2 + dir) * 64 + pp] = z; } }
    for (int idx = tid; idx < 64 * 16; idx += NTHR) { const int pp = idx >> 4, h = idx & 15; const int gi = (dir * 32 + g) * 64 + pp;
        const float a = fminf(p.lam_re[gi], -1e-4f) * dtf, b = p.lam_im[gi] * dtf;
        float qr, qi;
        if (a * a + b * b < 0.0625f) { qr = 1.0f; qi = 0.0f;
#pragma unroll
            for (int n = 8; n >= 2; --n) { const float inv = 1.0f / (float)n; const float tr = (a * qr - b * qi) * inv, ti = (a * qi + b * qr) * inv; qr = 1.0f + tr; qi = ti; } }
        else { float sn, cs; sincosf(b, &sn, &cs); const float er = expf(a); const float xr = er * cs - 1.0f, xi = er * sn, den = 1.0f / (a * a + b * b);
            qr = (xr * a + xi * b) * den; qi = (xi * a - xr * b) * den; }
        const float cr = qr * dtf, ci = qi * dtf;
        const float br = p.b_re[(size_t)gi * 16 + h], bi = p.b_im[(size_t)gi * 16 + h];
        const f32x2 bb = (f32x2){cr * br - ci * bi, cr * bi + ci * br}; BB[pp * 16 + h] = bb; if (pub) BBG[pp * 16 + h] = bb; }
    for (int idx = tid; idx < 16 * 64; idx += NTHR) { const int h = idx / 64, pp = idx % 64;
        const size_t gi = ((size_t)(dir * 32 + g) * 16 + h) * 64 + pp;
        CM[h * 65 + pp] = (f32x2){p.c_re[gi], p.c_im[gi]}; }
    __syncthreads();
    { const int dq = tid >> 8, h = (tid >> 4) & 15, hp = tid & 15, db = d0 + 4 * dq;
      float kacc[4] = {0.f, 0.f, 0.f, 0.f};
      for (int pp = 0; pp < 64; ++pp) { const f32x2 cm = CM[h * 65 + pp], bb = BB[pp * 16 + hp];
          const float wr_ = cm.x * bb.x - cm.y * bb.y, wi_ = cm.x * bb.y + cm.y * bb.x;
          const LAS f32x2* lp = LP + pp * LPD + db;
#pragma unroll
          for (int i = 0; i < 4; ++i) { const f32x2 z = lp[i]; kacc[i] += wr_ * z.x - wi_ * z.y; } }
#pragma unroll
      for (int i = 0; i < 4; ++i) KTG[(db + i) * 256 + h * 16 + hp] = kacc[i]; }
    __syncthreads();
}
__device__ __forceinline__ void s5_assemble(CParams& p, int o) {
    const int g = o >> 16, r = o & 65535;
    const f32x2* LPGg = (const f32x2*)(p.ws + WS_LPG) + (size_t)g * 2 * 33 * 64;
    const f32x2* BBGg = (const f32x2*)(p.ws + WS_BBG) + (size_t)g * 2 * 64 * 16;
    const float* KTGg = (const float*)(p.ws + WS_KTG) + (size_t)g * 2 * 32 * 256;
    float v[8]; bf16_t* dst;
    if (r < 512 * 96) { const int n = r / 96, k8 = r % 96, tau = n >> 4, h = n & 15;
        dst = (bf16_t*)(p.ws + WS_MMAT) + (size_t)g * 512 * 768 + (size_t)n * 768 + k8 * 8;
        if (k8 < 64) { const int sg = k8 >> 1, hb = (k8 & 1) * 8;
            f32x4 a0 = (f32x4){0.f, 0.f, 0.f, 0.f}, a1 = a0;
            if (sg <= tau) { const float* kp = KTGg + ((0 * 32 + (tau - sg)) * 16 + h) * 16 + hb; a0 += *(const f32x4*)kp; a1 += *(const f32x4*)(kp + 4); }
            if (sg >= tau) { const float* kp = KTGg + ((1 * 32 + (sg - tau)) * 16 + h) * 16 + hb; a0 += *(const f32x4*)kp; a1 += *(const f32x4*)(kp + 4); }
#pragma unroll
            for (int j = 0; j < 4; ++j) { v[j] = a0[j]; v[4 + j] = a1[j]; }
            if (sg == tau) { const float dsk = p.s5_d[g * 16 + h];
#pragma unroll
                for (int j = 0; j < 8; ++j) if (hb + j == h) v[j] += dsk; }
        } else { const int q = (k8 - 64) * 8, dir = q >> 7, ri = (q >> 6) & 1, pb = q & 63; const int e = dir == 0 ? (tau + 1) : (TCH - tau);
            const size_t ci = ((size_t)(dir * 32 + g) * 16 + h) * 64 + pb;
            const f32x2* zp = LPGg + (dir * 33 + e) * 64 + pb;
#pragma unroll
            for (int j = 0; j < 8; ++j) { const float cr = p.c_re[ci + j], cim = p.c_im[ci + j]; const f32x2 z = zp[j];
                v[j] = ri == 0 ? (cr * z.x - cim * z.y) : -(cr * z.y + cim * z.x); } }
    } else { const int r2 = r - 512 * 96, n = r2 >> 6, k8 = r2 & 63;
        const int dir = n >> 7, ri = (n >> 6) & 1, pp = n & 63, tau = k8 >> 1, hb = (k8 & 1) * 8;
        dst = (bf16_t*)(p.ws + WS_HMAT) + (size_t)g * 256 * 512 + (size_t)n * 512 + k8 * 8;
        const int e = dir == 0 ? (TCH - 1 - tau) : tau; const f32x2 z = LPGg[(dir * 33 + e) * 64 + pp];
        const f32x2* bp = BBGg + (dir * 64 + pp) * 16 + hb;
#pragma unroll
        for (int j = 0; j < 8; ++j) { const f32x2 bb = bp[j]; v[j] = ri == 0 ? (z.x * bb.x - z.y * bb.y) : (z.x * bb.y + z.y * bb.x); } }
    u32x4 ov; ov.x = cvt_pk_bf16(v[0], v[1]); ov.y = cvt_pk_bf16(v[2], v[3]); ov.z = cvt_pk_bf16(v[4], v[5]); ov.w = cvt_pk_bf16(v[6], v[7]);
    *(u32x4*)dst = ov;
}

__device__ __forceinline__ void norm_store(const f32x4 (&v)[4], const float* gvec, const float* shift, const float* scale, bf16_t* orow, int lane) {
    float s = 0.f;
#pragma unroll
    for (int j = 0; j < 4; ++j) s += (v[j].x * v[j].x + v[j].y * v[j].y) + (v[j].z * v[j].z + v[j].w * v[j].w);
    const float rstd = rsqrtf(wave_sum(s) * (1.0f / D) + 1e-6f);
#pragma unroll
    for (int j = 0; j < 4; ++j) { const int c = 4 * lane + 256 * j;
        const f32x4 gv = *(const f32x4*)(gvec + c), sh = *(const f32x4*)(shift + c), sc = *(const f32x4*)(scale + c);
        const f32x4 y = (v[j] * rstd * gv) * (1.0f + sc) + sh;
        u32x2 w; w.x = cvt_pk_bf16(y.x, y.y); w.y = cvt_pk_bf16(y.z, y.w); *(u32x2*)(orow + c) = w; }
}

#ifndef PH_MASK
#define PH_MASK 0xffffffffu
#endif
#define PH(k) ((PH_MASK >> (k)) & 1u)
#ifndef REP_MASK
#define REP_MASK 0u
#endif
#ifndef EXTRA_SYNCS
#define EXTRA_SYNCS 0
#endif
#define REP(k) ((int)((REP_MASK >> (k)) & 1u) + 1)
__global__ void __launch_bounds__(NTHR, 2) fwd_megakernel(Params p) {
    extern __shared__ __attribute__((aligned(16))) unsigned char lds_raw[];
    LAS unsigned char* lds = (LAS unsigned char*)lds_raw;
    cg::grid_group grid = cg::this_grid();
    const int G = gridDim.x, bid = blockIdx.x, NGW = G * NWAVES;
#define PHASE_IDS int tid = threadIdx.x; asm volatile("" : "+v"(tid)); const int lane = tid & 63, wave = __builtin_amdgcn_readfirstlane(tid >> 6), gw = bid * NWAVES + wave; (void)lane; (void)gw; \
    CParams* pp_ = (CParams*)__builtin_amdgcn_kernarg_segment_ptr(); asm volatile("" : "+s"(pp_)); CParams& p = *pp_; unsigned char* ws = p.ws; \
    bf16_t* WT_in = (bf16_t*)(ws + WS_WIN); bf16_t* WT_out = (bf16_t*)(ws + WS_WOUT); bf16_t* WT_glu = (bf16_t*)(ws + WS_WGLU); bf16_t* WT_1 = (bf16_t*)(ws + WS_W1); bf16_t* WT_2 = (bf16_t*)(ws + WS_W2); bf16_t* WT_pool = (bf16_t*)(ws + WS_WPOOL); float* MOD = (float*)(ws + WS_MOD); float* PR = (float*)(ws + WS_PR); float* PC = (float*)(ws + WS_PC); bf16_t* BUFA = (bf16_t*)(ws + WS_BUFA); float* SLOC = (float*)(ws + WS_SLOC); bf16_t* HD = (bf16_t*)(ws + WS_HD); bf16_t* UG = (bf16_t*)(ws + WS_UG); bf16_t* ZVG = (bf16_t*)(ws + WS_ZVG); bf16_t* YA = (bf16_t*)(ws + WS_YA); bf16_t* MMAT = (bf16_t*)(ws + WS_MMAT); bf16_t* HMAT = (bf16_t*)(ws + WS_HMAT); float* H = p.out; \
    (void)WT_in; (void)WT_out; (void)WT_glu; (void)WT_1; (void)WT_2; (void)WT_pool; (void)MOD; (void)PR; (void)PC; (void)BUFA; (void)SLOC; (void)HD; (void)UG; (void)ZVG; (void)YA; (void)MMAT; (void)HMAT; (void)H;
    unsigned char* ws = p.ws;
    Sched S; S.G = G; S.c = bid;
    unsigned* BAR = (unsigned*)(ws + WS_BAR);
    if (threadIdx.x < 4) ((LAS unsigned*)(lds + LDS_BARST_OFF))[threadIdx.x] = 0u;
    __syncthreads();
    XcdBarrier xbar = xcd_barrier_post(BAR, (volatile LAS unsigned*)(lds + LDS_BARST_OFF));
#define GRID_BAR() xcd_barrier(xbar)

#if PH(0)
    for (int rep_ = 0; rep_ < REP(0); ++rep_) { if (rep_) GRID_BAR(); PHASE_IDS
    for (int it = bid; it < 32; it += G) ada_item(p, lds, it, tid, wave, lane);
    for (int it = bid; it < 256; it += G) s5_part(p, lds, it >> 3, it & 7, tid);
    {
        LAS float* scr = (LAS float*)(lds + wave * 8704);
        constexpr int I_IN = 16 * 48, I_OUT = 16 * 32, I_GLU = 8 * 16, I_1 = 16 * 128, I_2 = 64 * 32, I_P = 4 * 8;
        constexpr int NIT = I_IN + I_OUT + I_GLU + 4 * I_P; (void)I_1; (void)I_2;
        for (int it = gw; it < NIT; it += NGW) { int r = it;
            if (r < I_IN) { transpose_item(p.w_in, 1024, 1536, WT_in, scr, r, lane); continue; } r -= I_IN;
            if (r < I_OUT) { transpose_item(p.w_out, 1024, 1024, WT_out, scr, r, lane); continue; } r -= I_OUT;
            if (r < I_GLU) { transpose_item(p.w_glu, 512, 512, WT_glu, scr, r, lane); continue; } r -= I_GLU;
            { const int gi = r / I_P; transpose_item(p.pool_w + (size_t)gi * 256 * 256, 256, 256, WT_pool + (size_t)gi * 256 * 256, scr, r % I_P, lane); } }
        for (int idx = bid * NTHR + tid; idx < 320 * 512; idx += G * NTHR) { const int pos = idx / 512, cidx = idx % 512, k = cidx & 255;
            const float omega = 1.0f / powf(10000.0f, (float)k / 256.0f); const float posf = pos < 256 ? (float)pos : (float)(pos - 256);
            const float ang = posf * omega; const float v = cidx < 256 ? sinf(ang) : cosf(ang);
            if (pos < 256) PR[pos * 512 + cidx] = v; else PC[(pos - 256) * 512 + cidx] = v; }
    }
    }
#endif
    if (p.cg_sync) grid.sync(); else GRID_BAR();

#if PH(1)
    for (int rep_ = 0; rep_ < REP(1); ++rep_) { if (rep_) GRID_BAR(); PHASE_IDS
    for (int rowb = gw; rowb < MROWS; rowb += 4 * NGW) {
        f32x4 v[4][4];
#pragma unroll
        for (int r = 0; r < 4; ++r) { const int row = rowb + r * NGW;
            if (row < L) { const f32x4* xr = (const f32x4*)(p.x + (size_t)row * D) + lane;
#pragma unroll
                for (int j = 0; j < 4; ++j) v[r][j] = xr[64 * j]; }
            else if (row < MROWS) { const f32x4* xr = (const f32x4*)(p.ctx + (size_t)(row - L) * D) + lane;
#pragma unroll
                for (int j = 0; j < 4; ++j) v[r][j] = xr[64 * j]; } }
#pragma unroll
        for (int r = 0; r < 4; ++r) { const int row = rowb + r * NGW;
            if (row < L) {
#pragma unroll
                for (int j = 0; j < 4; ++j) { const f32x4 pv = j < 2 ? *((const f32x4*)(PR + (size_t)(row >> 6) * 512 + j * 256) + lane) : *((const f32x4*)(PC + (size_t)(row & 63) * 512 + (j - 2) * 256) + lane);
                    v[r][j] += pv; }
                norm_store(v[r], p.norm_mix_g, MOD + 0 * 1024, MOD + 1 * 1024, BUFA + (size_t)row * D, lane); }
            else if (row < MROWS) norm_store(v[r], p.norm_mix_g, MOD + 6144 + 0 * 1024, MOD + 6144 + 1 * 1024, BUFA + (size_t)row * D, lane); }
    }
    }
#endif
    GRID_BAR();

#if PH(2)
    for (int rep_ = 0; rep_ < REP(2); ++rep_) { if (rep_) GRID_BAR(); PHASE_IDS
    { GemmD g{}; g.A = BUFA; g.Bt = WT_in; g.lda = 1024; g.ldb = 1024; g.K = 1024; g.sA = 0; g.sB = 0;
      S.nM = MROWS / 256; S.nN = 6; S.nB = 1; EpiWin E; E.UG = UG; E.ZVG = ZVG; gemm_phase(lds, g, S, E); }
    { int fi = (MROWS / 256) * 6 - G; if (fi < 0 || fi >= G) fi = 0;
      if (bid >= fi) for (int o = (bid - fi) * NTHR + tid; o < 32 * 65536; o += (G - fi) * NTHR) s5_assemble(p, o); }
    }
#endif
    GRID_BAR();

#if PH(3)
    for (int rep_ = 0; rep_ < REP(3); ++rep_) { if (rep_) GRID_BAR(); PHASE_IDS
    { GemmD g{}; g.A = UG; g.Bt = HMAT; g.lda = UGK; g.ldb = 512; g.K = 512; g.sA = (size_t)UGR * UGK; g.sB = (size_t)256 * 512;
      S.nM = 3; S.nN = 1; S.nB = 32; EpiF32Store E; E.C = SLOC; E.ldc = 256; E.sC = (size_t)UGR * 256; for (int grep_ = 0; grep_ < REP(14); ++grep_) { gemm_phase(lds, g, S, E); __syncthreads(); } }
    __syncthreads();
    for (int crep_ = 0; crep_ < REP(13); ++crep_) {   PHASE_IDS
        LAS bf16_t* vbs = (LAS bf16_t*)lds;
        LAS float* outs = (LAS float*)(lds + 62 * 512 * 2);
        const float* cw = p.conv_w;
        for (int it = (G == 256) ? bid : (bid + 160) % G; it < L / 32; it += (G == 256) ? (bid < 96 ? L : 160) : G) { const int t0 = it * 32;
            { u32x4 vv[8], gg[8];
#pragma unroll
              for (int k = 0; k < 8; ++k) { const int idx = tid + k * NTHR, r = idx >> 6, c8 = idx & 63; int t = t0 - 15 + r; t = t < 0 ? 0 : (t > L - 1 ? L - 1 : t);
                  if (idx < 62 * 64) { vv[k] = *(const u32x4*)(ZVG + (size_t)t * 1024 + c8 * 8); gg[k] = *(const u32x4*)(ZVG + (size_t)t * 1024 + 512 + c8 * 8); } }
#pragma unroll
              for (int k = 0; k < 8; ++k) { const int idx = tid + k * NTHR, r = idx >> 6, c8 = idx & 63; const int t = t0 - 15 + r;
                  if (idx < 62 * 64) { u32x4 o = (u32x4){0u, 0u, 0u, 0u};
                      if (t >= 0 && t < L) {
                          o.x = cvt_pk_bf16(bf_lo(vv[k].x) * sigmoidf_(bf_lo(gg[k].x)), bf_hi(vv[k].x) * sigmoidf_(bf_hi(gg[k].x)));
                          o.y = cvt_pk_bf16(bf_lo(vv[k].y) * sigmoidf_(bf_lo(gg[k].y)), bf_hi(vv[k].y) * sigmoidf_(bf_hi(gg[k].y)));
                          o.z = cvt_pk_bf16(bf_lo(vv[k].z) * sigmoidf_(bf_lo(gg[k].z)), bf_hi(vv[k].z) * sigmoidf_(bf_hi(gg[k].z)));
                          o.w = cvt_pk_bf16(bf_lo(vv[k].w) * sigmoidf_(bf_lo(gg[k].w)), bf_hi(vv[k].w) * sigmoidf_(bf_hi(gg[k].w))); }
                      *(LAS u32x4*)(vbs + r * 512 + c8 * 8) = o; } } }
            __syncthreads();
            { const int cp = tid & 255, th = tid >> 8;
              f32x2 a2[16];
#pragma unroll
              for (int o = 0; o < 16; ++o) a2[o] = (f32x2){0.f, 0.f};
              f32x2 wv[31];
              const float* cwp = cw + 2 * cp; asm volatile("" : "+v"(cwp));
#pragma unroll
              for (int k = 0; k < 31; ++k) wv[k] = *(const f32x2*)(cwp + k * 512);
#pragma unroll
              for (int j = 0; j < 46; ++j) { const unsigned xw = *(const LAS unsigned*)(vbs + (th * 16 + j) * 512 + 2 * cp); const f32x2 x2 = (f32x2){bf_lo(xw), bf_hi(xw)};
#pragma unroll
                  for (int o = 0; o < 16; ++o) { const int k = j - o; if (k >= 0 && k <= 30) a2[o] = __builtin_elementwise_fma(wv[k], x2, a2[o]); } }
              const f32x2 cb = *(const f32x2*)(p.conv_b + 2 * cp);
#pragma unroll
              for (int o = 0; o < 16; ++o) *(LAS f32x2*)(outs + (th * 16 + o) * 512 + 2 * cp) = a2[o] + cb; }
            __syncthreads();
#pragma unroll
            for (int q = 0; q < 4; ++q) { const int to = wave * 4 + q;
                const f32x4 y0 = *(const LAS f32x4*)(outs + to * 512 + lane * 8), y1 = *(const LAS f32x4*)(outs + to * 512 + lane * 8 + 4);
                const float mean = wave_sum((y0.x + y0.y) + (y0.z + y0.w) + (y1.x + y1.y) + (y1.z + y1.w)) * (1.0f / 512.0f);
                const f32x4 d0 = y0 - mean, d1 = y1 - mean;
                const float var = wave_sum((d0.x * d0.x + d0.y * d0.y) + (d0.z * d0.z + d0.w * d0.w) + (d1.x * d1.x + d1.y * d1.y) + (d1.z * d1.z + d1.w * d1.w)) * (1.0f / 512.0f);
                const float rstd = rsqrtf(var + 1e-6f);
                const f32x4 g0 = *(const f32x4*)(p.ln_g + lane * 8), g1 = *(const f32x4*)(p.ln_g + lane * 8 + 4), b0 = *(const f32x4*)(p.ln_b + lane * 8), b1 = *(const f32x4*)(p.ln_b + lane * 8 + 4);
                f32x4 z0 = d0 * rstd * g0 + b0, z1 = d1 * rstd * g1 + b1;
#pragma unroll
                for (int j = 0; j < 4; ++j) { z0[j] = z0[j] * sigmoidf_(z0[j]); z1[j] = z1[j] * sigmoidf_(z1[j]); }
                u32x4 w; w.x = cvt_pk_bf16(z0.x, z0.y); w.y = cvt_pk_bf16(z0.z, z0.w); w.z = cvt_pk_bf16(z1.x, z1.y); w.w = cvt_pk_bf16(z1.z, z1.w);
                *(u32x4*)(BUFA + (size_t)(t0 + to) * 1024 + 512 + lane * 8) = w; }
            __syncthreads();
        }
    }
    }
#endif
    GRID_BAR();

#if PH(4)
    for (int rep_ = 0; rep_ < REP(4); ++rep_) { if (rep_) GRID_BAR(); PHASE_IDS
    if (bid >= 64 && G > 64) { for (int i2 = bid - 64; i2 < 160; i2 += G - 64) ada_item(p, lds, i2 < 64 ? 32 + i2 : 32 + i2, tid, wave, lane); }
    else if (G <= 64) { for (int i2 = bid; i2 < 160; i2 += G) ada_item(p, lds, 32 + i2, tid, wave, lane); }
    if (bid >= 64 && G > 64) mlp_transposes(p, lds, 0, 3072, (bid - 64) * NWAVES + wave, (G - 64) * NWAVES, wave, lane);
    else if (G <= 64) mlp_transposes(p, lds, 0, 3072, gw, NGW, wave, lane);
    for (int it = bid; it < 64; it += G) { const int g = it >> 1, dir = it & 1;
        LAS f32x2* EX = (LAS f32x2*)lds;
        const f32x2 lam = ((const f32x2*)(ws + WS_LAMT))[(g * 2 + dir) * 64 + lane];
        float pr = lam.x, pi = lam.y;
#pragma unroll
        for (int q = 0; q < 6; ++q) { const float nr = pr * pr - pi * pi, ni = 2.0f * pr * pi; pr = nr; pi = ni; }
        const float* sl = SLOC + (size_t)g * UGR * 256 + dir * 128 + lane;
        bf16_t* ug = UG + (size_t)g * UGR * UGK + 512 + dir * 128 + lane;
        const long sstp = dir == 0 ? 256 : -256, ustp = dir == 0 ? UGK : -UGK; const int ch0 = dir == 0 ? wave * 64 : NCH - 1 - wave * 64;
        float sr = 0.f, si = 0.f;
        if (wave == 0) {
            float cr[8], ci[8];
#pragma unroll
            for (int q = 0; q < 8; ++q) { const int ch = dir == 0 ? NCH + q : NCH + 7 - q; cr[q] = sl[(size_t)ch * 256]; ci[q] = sl[(size_t)ch * 256 + 64]; }
#pragma unroll
            for (int q = 0; q < 8; ++q) { const float nr = lam.x * sr - lam.y * si + cr[q], ni = lam.x * si + lam.y * sr + ci[q]; sr = nr; si = ni; } }
        float ir = sr, ii = si;
        { const float* sp = sl + (size_t)ch0 * 256;
#pragma unroll 1
          for (int jb = 0; jb < 4; ++jb) { float br[16], bi[16];
#pragma unroll
              for (int j = 0; j < 16; ++j) { br[j] = sp[(long)j * sstp]; bi[j] = sp[(long)j * sstp + 64]; }
#pragma unroll
              for (int j = 0; j < 16; ++j) { const float nr = lam.x * sr - lam.y * si + br[j], ni = lam.x * si + lam.y * sr + bi[j]; sr = nr; si = ni; }
              sp += 16 * sstp; } }
        EX[wave * 64 + lane] = (f32x2){sr, si};
        __syncthreads();
        if (wave > 0) { f32x2 f = EX[lane];
            for (int j = 1; j < wave; ++j) { const f32x2 e = EX[j * 64 + lane]; const float nr = pr * f.x - pi * f.y + e.x, ni = pr * f.y + pi * f.x + e.y; f.x = nr; f.y = ni; }
            ir = f.x; ii = f.y; }
        sr = ir; si = ii;
        { const float* sp = sl + (size_t)ch0 * 256; bf16_t* up = ug + (size_t)ch0 * UGK;
#pragma unroll 1
          for (int jb = 0; jb < 4; ++jb) { float br[16], bi[16];
#pragma unroll
              for (int j = 0; j < 16; ++j) { br[j] = sp[(long)j * sstp]; bi[j] = sp[(long)j * sstp + 64]; }
#pragma unroll
              for (int j = 0; j < 16; ++j) { const unsigned w = cvt_pk_bf16(sr, si);
                  up[(long)j * ustp] = (bf16_t)(w & 0xffffu); up[(long)j * ustp + 64] = (bf16_t)(w >> 16);
                  const float nr = lam.x * sr - lam.y * si + br[j], ni = lam.x * si + lam.y * sr + bi[j]; sr = nr; si = ni; }
              sp += 16 * sstp; up += 16 * ustp; } }
        __syncthreads();
    }
    }
#endif
    GRID_BAR();

#if PH(5)
    for (int rep_ = 0; rep_ < REP(5); ++rep_) { if (rep_) GRID_BAR(); PHASE_IDS
    { GemmD g{}; g.A = UG; g.Bt = MMAT; g.lda = UGK; g.ldb = 768; g.K = 768; g.sA = (size_t)UGR * UGK; g.sB = (size_t)512 * 768;
      S.nM = 2; S.nN = 2; S.nB = 32; EpiY E; E.YA = YA; gemm_phase(lds, g, S, E); }
    if (bid >= 128 && G > 128) mlp_transposes(p, lds, 3072, 3072, (bid - 128) * NWAVES + wave, (G - 128) * NWAVES, wave, lane);
    else if (G <= 128) { __syncthreads(); mlp_transposes(p, lds, 3072, 3072, gw, NGW, wave, lane); }
    }
#endif
    GRID_BAR();

#if PH(6)
    for (int rep_ = 0; rep_ < REP(6); ++rep_) { if (rep_) GRID_BAR(); PHASE_IDS
    { GemmD g{}; g.A = YA; g.Bt = WT_glu; g.lda = 512; g.ldb = 512; g.K = 512; g.sA = 0; g.sB = 0;
      S.nM = L / 256; S.nN = 2; S.nB = 1; EpiGlu E; E.YA = YA; E.A1 = BUFA; gemm_phase(lds, g, S, E); }
    if (bid >= 128 && G > 128) mlp_transposes(p, lds, 6144, 2048, (bid - 128) * NWAVES + wave, (G - 128) * NWAVES, wave, lane);
    else if (G <= 128) { __syncthreads(); mlp_transposes(p, lds, 6144, 2048, gw, NGW, wave, lane); }
    }
#endif
    GRID_BAR();

#if PH(7)
    for (int rep_ = 0; rep_ < REP(7); ++rep_) { if (rep_) GRID_BAR(); PHASE_IDS
    { GemmD g{}; g.A = BUFA; g.Bt = WT_out; g.lda = 1024; g.ldb = 1024; g.K = 1024; g.sA = 0; g.sB = 0;
      S.nM = L / 256; S.nN = 4; S.nB = 1; EpiWout E; E.x = p.x; E.PR = PR; E.PC = PC; E.g1 = MOD + 2 * 1024; E.H = H; gemm_phase(lds, g, S, E); }
    }
#endif
    GRID_BAR();

#define mod (MOD + (layer == 0 ? 0 : 2 * 6144))
    { constexpr int layer = 0;
#if PH(10)
    for (int rep_ = 0; rep_ < REP(10); ++rep_) { if (rep_) GRID_BAR(); PHASE_IDS
        for (int rowb = gw; rowb < L; rowb += 4 * NGW) { f32x4 v[4][4];
#pragma unroll
            for (int r = 0; r < 4; ++r) { const int row = rowb + r * NGW; if (row < L) { const f32x4* hr = (const f32x4*)(H + (size_t)row * D) + lane;
#pragma unroll
                for (int j = 0; j < 4; ++j) v[r][j] = hr[64 * j]; } }
#pragma unroll
            for (int r = 0; r < 4; ++r) { const int row = rowb + r * NGW; if (row < L) norm_store(v[r], p.norm_mlp_g + layer * D, mod + 3 * 1024, mod + 4 * 1024, BUFA + (size_t)row * D, lane); } }
    }
#endif
        GRID_BAR();
#if PH(11)
    for (int rep_ = 0; rep_ < REP(11); ++rep_) { if (rep_) GRID_BAR(); PHASE_IDS
        { GemmD g{}; g.A = BUFA; g.Bt = WT_1 + (size_t)layer * 4096 * 1024; g.lda = 1024; g.ldb = 1024; g.K = 1024; g.sA = 0; g.sB = 0;
          S.nM = L / 256; S.nN = 16; S.nB = 1; EpiMlp1 E; E.HD = HD; gemm_phase(lds, g, S, E); }
    }
#endif
        GRID_BAR();
#if PH(12)
    for (int rep_ = 0; rep_ < REP(12); ++rep_) { if (rep_) GRID_BAR(); PHASE_IDS
        { GemmD g{}; g.A = HD; g.Bt = WT_2 + (size_t)layer * 1024 * 4096; g.lda = 4096; g.ldb = 4096; g.K = 4096; g.sA = 0; g.sB = 0;
          S.nM = L / 256; S.nN = 4; S.nB = 1; EpiMlp2 E; E.g2 = mod + 5 * 1024; E.H = H; gemm_phase(lds, g, S, E); }
    }
#endif
        GRID_BAR();
    }
    { constexpr int layer = 1;
#if PH(8)
    for (int rep_ = 0; rep_ < REP(8); ++rep_) { if (rep_) GRID_BAR(); PHASE_IDS
            LAS bf16_t* ns = (LAS bf16_t*)lds;
            for (int it = bid; it < L / 32; it += G) { const int t0 = it * 32;
                for (int rb = wave; rb < 47; rb += 3 * NWAVES) { f32x4 v[3][4];
#pragma unroll
                    for (int q = 0; q < 3; ++q) { const int r = rb + q * NWAVES; int t = t0 - 8 + r; t = t < 0 ? 0 : (t > L - 1 ? L - 1 : t);
                        if (r < 47) { const f32x4* hr = (const f32x4*)(H + (size_t)t * D) + lane;
#pragma unroll
                            for (int j = 0; j < 4; ++j) v[q][j] = hr[64 * j]; } }
#pragma unroll
                    for (int q = 0; q < 3; ++q) { const int r = rb + q * NWAVES; const int t = t0 - 8 + r;
                        if (r < 47) {
                            if (t >= 0 && t < L) { float s = 0.f;
#pragma unroll
                                for (int j = 0; j < 4; ++j) s += (v[q][j].x * v[q][j].x + v[q][j].y * v[q][j].y) + (v[q][j].z * v[q][j].z + v[q][j].w * v[q][j].w);
                                const float rstd = rsqrtf(wave_sum(s) * (1.0f / D) + 1e-6f);
#pragma unroll
                                for (int j = 0; j < 4; ++j) { const int c = 4 * lane + 256 * j;
                                    const f32x4 gv = *(const f32x4*)(p.norm_mix_g + D + c), sh = *(const f32x4*)(mod + c), sc = *(const f32x4*)(mod + 1024 + c);
                                    const f32x4 y = (v[q][j] * rstd * gv) * (1.0f + sc) + sh;
                                    u32x2 w; w.x = cvt_pk_bf16(y.x, y.y); w.y = cvt_pk_bf16(y.z, y.w); *(LAS u32x2*)(ns + r * 1024 + c) = w; }
                            } else {
#pragma unroll
                                for (int j = 0; j < 4; ++j) *(LAS u32x2*)(ns + r * 1024 + 4 * lane + 256 * j) = (u32x2){0u, 0u}; } } } }
                __syncthreads();
                { const int gi = tid >> 7, win = 2 << gi, left = win >> 1, right = win - 1 - left;
                  float s0 = 0.f, s1 = 0.f;
                  for (int r = 8 - left; r <= 8 + right; ++r) { const unsigned w = *(const LAS unsigned*)(ns + r * 1024 + 2 * tid); s0 += bf_lo(w); s1 += bf_hi(w); }
                  for (int to = 0; to < 32; ++to) { const int t = t0 + to;
                      if (to > 0) { const unsigned wn = *(const LAS unsigned*)(ns + (to + 8 + right) * 1024 + 2 * tid), wo = *(const LAS unsigned*)(ns + (to + 7 - left) * 1024 + 2 * tid);
                          s0 += bf_lo(wn) - bf_lo(wo); s1 += bf_hi(wn) - bf_hi(wo); }
                      const unsigned ws_ = *(const LAS unsigned*)(ns + (to + 8) * 1024 + 2 * tid);
                      const int lo = max(t - left, 0), hi = min(t + right, L - 1); const float inv = 1.0f / (float)(hi - lo + 1);
                      *(unsigned*)(BUFA + (size_t)t * 1024 + 2 * tid) = cvt_pk_bf16(s0 * inv - bf_lo(ws_), s1 * inv - bf_hi(ws_)); } }
                __syncthreads();
            }
    }
#endif
            GRID_BAR();
#if PH(9)
    for (int rep_ = 0; rep_ < REP(9); ++rep_) { if (rep_) GRID_BAR(); PHASE_IDS
            { GemmD g{}; g.A = BUFA; g.Bt = WT_pool; g.lda = 1024; g.ldb = 256; g.K = 256; g.sA = 256; g.sB = (size_t)256 * 256;
              S.nM = L / 256; S.nN = 1; S.nB = 4; EpiPool E; E.g1 = mod + 2 * 1024; E.pb = p.pool_b; E.ps = p.pool_scale; E.H = H; gemm_phase(lds, g, S, E); }
    }
#endif
            GRID_BAR();
#if PH(10)
    for (int rep_ = 0; rep_ < REP(10); ++rep_) { if (rep_) GRID_BAR(); PHASE_IDS
        for (int rowb = gw; rowb < L; rowb += 4 * NGW) { f32x4 v[4][4];
#pragma unroll
            for (int r = 0; r < 4; ++r) { const int row = rowb + r * NGW; if (row < L) { const f32x4* hr = (const f32x4*)(H + (size_t)row * D) + lane;
#pragma unroll
                for (int j = 0; j < 4; ++j) v[r][j] = hr[64 * j]; } }
#pragma unroll
            for (int r = 0; r < 4; ++r) { const int row = rowb + r * NGW; if (row < L) norm_store(v[r], p.norm_mlp_g + layer * D, mod + 3 * 1024, mod + 4 * 1024, BUFA + (size_t)row * D, lane); } }
    }
#endif
        GRID_BAR();
#if PH(11)
    for (int rep_ = 0; rep_ < REP(11); ++rep_) { if (rep_) GRID_BAR(); PHASE_IDS
        { GemmD g{}; g.A = BUFA; g.Bt = WT_1 + (size_t)layer * 4096 * 1024; g.lda = 1024; g.ldb = 1024; g.K = 1024; g.sA = 0; g.sB = 0;
          S.nM = L / 256; S.nN = 16; S.nB = 1; EpiMlp1 E; E.HD = HD; gemm_phase(lds, g, S, E); }
    }
#endif
        GRID_BAR();
#if PH(12)
    for (int rep_ = 0; rep_ < REP(12); ++rep_) { if (rep_) GRID_BAR(); PHASE_IDS
        { GemmD g{}; g.A = HD; g.Bt = WT_2 + (size_t)layer * 1024 * 4096; g.lda = 4096; g.ldb = 4096; g.K = 4096; g.sA = 0; g.sB = 0;
          S.nM = L / 256; S.nN = 4; S.nB = 1; EpiMlp2 E; E.g2 = mod + 5 * 1024; E.H = H; gemm_phase(lds, g, S, E); }
    }
#endif
        GRID_BAR();
    }

    for (int es_ = 0; es_ < EXTRA_SYNCS; ++es_) GRID_BAR();
    { PHASE_IDS
    for (int rowb = gw; rowb < L; rowb += 4 * NGW) { f32x4 v[4][4];
#pragma unroll
        for (int r = 0; r < 4; ++r) { const int row = rowb + r * NGW; if (row < L) { const f32x4* hr = (const f32x4*)(H + (size_t)row * D) + lane;
#pragma unroll
            for (int j = 0; j < 4; ++j) v[r][j] = hr[64 * j]; } }
#pragma unroll
        for (int r = 0; r < 4; ++r) { const int row = rowb + r * NGW; if (row < L) { f32x4* hr = (f32x4*)(H + (size_t)row * D) + lane; float s = 0.f;
#pragma unroll
            for (int j = 0; j < 4; ++j) s += (v[r][j].x * v[r][j].x + v[r][j].y * v[r][j].y) + (v[r][j].z * v[r][j].z + v[r][j].w * v[r][j].w);
            const float rstd = rsqrtf(wave_sum(s) * (1.0f / D) + 1e-6f);
#pragma unroll
            for (int j = 0; j < 4; ++j) { const f32x4 gv = *((const f32x4*)p.final_g + lane + 64 * j); hr[64 * j] = v[r][j] * rstd * gv; } } } }
    }
}

extern "C" void kernel_launch(void* const* d_in, const int* in_sizes, int n_in, void* d_out, int out_size, void* d_ws, size_t ws_size, hipStream_t stream) {
    static int grid_blocks = 0;
    if (grid_blocks == 0) {
        int dev = 0, cus = 0, per_cu = 0;
        if (hipGetDevice(&dev) != hipSuccess || hipDeviceGetAttribute(&cus, hipDeviceAttributeMultiprocessorCount, dev) != hipSuccess) { fprintf(stderr, "kernel_launch: device query failed\n"); grid_blocks = -1; return; }
        if (hipFuncSetAttribute((const void*)fwd_megakernel, hipFuncAttributeMaxDynamicSharedMemorySize, LDS_BYTES) != hipSuccess) { fprintf(stderr, "kernel_launch: hipFuncSetAttribute failed\n"); grid_blocks = -1; return; }
        if (hipOccupancyMaxActiveBlocksPerMultiprocessor(&per_cu, (const void*)fwd_megakernel, NTHR, LDS_BYTES) != hipSuccess || per_cu < 1) { fprintf(stderr, "kernel_launch: occupancy query says %d blocks per CU\n", per_cu); (void)hipGetLastError(); }
        if (ws_size < WS_END || n_in != 29 || out_size != L * D) { fprintf(stderr, "kernel_launch: unexpected sizes (ws %zu need %zu, n_in %d, out %d)\n", ws_size, (size_t)WS_END, n_in, out_size); grid_blocks = -1; return; }
        grid_blocks = cus;
    }
    if (grid_blocks < 0) return;
    Params p{};
    const float** f = (const float**)&p;
    for (int i = 0; i < 29; ++i) f[i] = (const float*)d_in[i];
    p.out = (float*)d_out; p.ws = (unsigned char*)d_ws; p.cg_sync = 0; p.pad = 0;
    if (hipMemsetAsync((unsigned char*)d_ws + WS_BAR, 0, (size_t)XCD_BAR_WORDS_C * 4, stream) != hipSuccess) { fprintf(stderr, "kernel_launch: hipMemsetAsync of the barrier words failed\n"); return; }
    void* args[] = {&p};
    hipError_t e = hipLaunchCooperativeKernel((const void*)fwd_megakernel, dim3(grid_blocks), dim3(NTHR), args, LDS_BYTES, stream);
    if (e != hipSuccess) fprintf(stderr, "cooperative launch failed: %s (grid %d)\n", hipGetErrorString(e), grid_blocks);
}
```

```cpp
#include <hip/hip_runtime.h>
#include <hip/hip_cooperative_groups.h>
#include <cstdio>
namespace cg = cooperative_groups;

#define LAS __attribute__((address_space(3)))
typedef unsigned short bf16_t;
typedef short bf16x8 __attribute__((ext_vector_type(8)));
typedef float f32x4 __attribute__((ext_vector_type(4)));
typedef float f32x2 __attribute__((ext_vector_type(2)));
typedef unsigned u32x4 __attribute__((ext_vector_type(4)));
typedef unsigned u32x2 __attribute__((ext_vector_type(2)));

constexpr int L = 16384, D = 1024, NCTX = 256, MROWS = L + NCTX, DFF = 4096;
constexpr int TCH = 32;
constexpr int NCH = L / TCH;
constexpr int UGR = 768, UGK = 768;
constexpr int NTHR = 512, NWAVES = 8;
constexpr int LDS_BYTES = 136 * 1024;
constexpr int XCD_BAR_WORDS_C = 3456;
constexpr int LDS_BARST_OFF = LDS_BYTES - 16;

constexpr size_t WS_WIN = 0;
constexpr size_t WS_WOUT = WS_WIN + (size_t)1536 * 1024 * 2;
constexpr size_t WS_WGLU = WS_WOUT + (size_t)1024 * 1024 * 2;
constexpr size_t WS_W1 = WS_WGLU + (size_t)512 * 512 * 2;
constexpr size_t WS_W2 = WS_W1 + (size_t)2 * 4096 * 1024 * 2;
constexpr size_t WS_WPOOL = WS_W2 + (size_t)2 * 4096 * 1024 * 2;
constexpr size_t WS_MOD = WS_WPOOL + (size_t)4 * 256 * 256 * 2;
constexpr size_t WS_PR = WS_MOD + (size_t)3 * 6144 * 4;
constexpr size_t WS_PC = WS_PR + (size_t)256 * 512 * 4;
constexpr size_t WS_LAMT = WS_PC + (size_t)64 * 512 * 4;
constexpr size_t WS_LPG = WS_LAMT + (size_t)64 * 64 * 8;
constexpr size_t WS_BBG = WS_LPG + (size_t)64 * 33 * 64 * 8;
constexpr size_t WS_KTG = WS_BBG + (size_t)64 * 64 * 16 * 8;
constexpr size_t WS_SS = WS_KTG + (size_t)64 * 32 * 256 * 4;
constexpr size_t WS_B1 = WS_SS + (size_t)2 * L * 4;
constexpr size_t WS_ACC_BYTES = (size_t)2 * L * 4 + (size_t)2 * DFF * 4;
constexpr size_t WS_SSP = WS_SS + WS_ACC_BYTES;
constexpr size_t WS_BAR = WS_SSP + (size_t)2 * L * 16 * 4;
constexpr size_t WS_BUFA = WS_BAR + (size_t)XCD_BAR_WORDS_C * 4;
constexpr size_t WS_SLOC = WS_BUFA + (size_t)MROWS * 1024 * 2;
constexpr size_t WS_HB = WS_SLOC;
constexpr size_t WS_BIG = WS_SLOC + (size_t)L * 1024 * 2;
static_assert((size_t)32 * UGR * 256 * 4 <= (size_t)L * 1024 * 2, "SLOC must fit in the HB slot");
constexpr size_t WS_HD = WS_BIG;
constexpr size_t WS_UG = WS_BIG;
constexpr size_t WS_ZVG = WS_UG + (size_t)32 * UGR * UGK * 2;
constexpr size_t WS_YA = WS_ZVG + (size_t)L * 1024 * 2;
constexpr size_t WS_MMAT = WS_YA + (size_t)L * 512 * 2;
constexpr size_t WS_HMAT = WS_MMAT + (size_t)32 * 512 * 768 * 2;
constexpr size_t WS_BIG_END_A = WS_HMAT + (size_t)32 * 256 * 512 * 2;
constexpr size_t WS_END = WS_BIG + (size_t)L * DFF * 2;
static_assert(WS_BIG_END_A <= WS_END, "alias region overflow");
static_assert(WS_END <= (size_t)256 * 1024 * 1024, "workspace too large");

__device__ __forceinline__ unsigned cvt_pk_bf16(float lo, float hi) { unsigned r; asm("v_cvt_pk_bf16_f32 %0, %1, %2" : "=v"(r) : "v"(lo), "v"(hi)); return r; }
__device__ __forceinline__ float bf_lo(unsigned w) { return __uint_as_float(w << 16); }
__device__ __forceinline__ float bf_hi(unsigned w) { return __uint_as_float(w & 0xffff0000u); }
__device__ __forceinline__ float wave_sum(float v) {
#pragma unroll
    for (int o = 1; o < 64; o <<= 1) v += __shfl_xor(v, o);
    return v;
}
__device__ __forceinline__ float sigmoidf_(float x) { return __builtin_amdgcn_rcpf(1.0f + __builtin_amdgcn_exp2f(-1.4426950408889634f * x)); }
__device__ __forceinline__ float gelu_tanh(float x) { const float z = 0.7978845608028654f * (x + 0.044715f * x * x * x); return x * __builtin_amdgcn_rcpf(1.0f + __builtin_amdgcn_exp2f(-2.8853900817779268f * z)); }

constexpr int BM = 256, BK = 64, HALF = 128, HTB = HALF * BK * 2, STAGE_BYTES = 8 * HTB, NXCD = 8, WGM = 8;
__device__ __forceinline__ int lds_byte(int r, int c) { const int st = (r >> 4) * 2 + (c >> 5), rr = r & 15, cc = c & 31, ob = rr * 64 + cc * 2; return st * 1024 + (ob ^ (((ob >> 9) & 1) << 5)); }
__device__ __forceinline__ void stage_rc(int b, int& R, int& C) { const int st = b / 1024, sb = b % 1024, swz = sb ^ (((sb >> 9) & 1) << 5); R = (st >> 1) * 16 + swz / 64; C = (st & 1) * 32 + (swz % 64) / 2; }
__device__ __forceinline__ int perm32(int rho) { const int n = rho >> 4, i = rho & 15; return 8 * (i >> 2) + 4 * n + (i & 3); }

struct Unit { int pm, pn, g; };
struct GemmD { const bf16_t* A; const bf16_t* Bt; int lda, ldb, K, pad; size_t sA, sB; };
struct Sched {
    int nM, nN, nB, G, c;
    __device__ __forceinline__ bool next(int i, Unit& u) const {
        const int per = nM * nN, nwg = per * nB;
        const long Lq = (long)i * G + c; if (Lq >= nwg) return false;
        if (nB == 1) {
            int wgid = (int)Lq; { const int q = nwg / NXCD, r = nwg % NXCD, xcd = wgid % NXCD, off = wgid / NXCD; wgid = (xcd < r ? xcd * (q + 1) : r * (q + 1) + (xcd - r) * q) + off; }
            const int nig = WGM * nN, gid = wgid / nig, fm = gid * WGM, gsz = (nM - fm) < WGM ? (nM - fm) : WGM;
            u.pm = fm + ((wgid % nig) % gsz); u.pn = (wgid % nig) / gsz; u.g = 0;
        } else { const int q = (int)Lq; u.g = q / per; const int r = q % per; u.pm = r / nN; u.pn = r % nN; }
        return true;
    }
};

template <class Epi>
__device__ __forceinline__ void gemm_phase(LAS unsigned char* lds, const GemmD g, const Sched& S, const Epi& E) {
    int tid = threadIdx.x; asm volatile("" : "+v"(tid));
    const int wid = __builtin_amdgcn_readfirstlane(tid >> 6), lane = tid & 63, wr = wid >> 2, wc = wid & 3, fr = lane & 15, fq = lane >> 4;
    int K = g.K; asm volatile("" : "+s"(K));
    const int nt = K / BK;
    unsigned voffA[2], voffB[2];
#pragma unroll
    for (int i = 0; i < 2; ++i) { int R, C; stage_rc(tid * 16 + i * 8192, R, C); const int Rb = Epi::PERM ? ((R & ~31) + perm32(R & 31)) : R;
        voffA[i] = (unsigned)(R * g.lda + C) * 2u; voffB[i] = (unsigned)(Rb * g.ldb + C) * 2u; }
    const size_t kstep = (size_t)(BK * 2);
    const size_t hstepA = (size_t)HALF * g.lda * 2, hstepB = (size_t)HALF * g.ldb * 2;
    const size_t tstepA = 2 * hstepA, tstepB = 2 * hstepB;
    const unsigned ldsw = (unsigned)wid * 1024u;
    const int aoff = lds_byte(wr * 64 + fr, fq * 8), boff = lds_byte(wc * 32 + fr, fq * 8);
#define PG8_SA(b, h) (((b) * 2 + (h)) * HTB)
#define PG8_SB(b, h) ((4 + (b) * 2 + (h)) * HTB)
#define PG8_STAGE(bufoff, gbase, voff) do { _Pragma("unroll") for (int _i = 0; _i < 2; ++_i) \
        __builtin_amdgcn_global_load_lds((const unsigned*)((const char*)(gbase) + (voff)[_i]), (LAS unsigned*)(lds + (bufoff) + ldsw + _i * 8192), 16, 0, 0); } while (0)
#define PG8_LDA(dst, b, h) do { _Pragma("unroll") for (int m = 0; m < 4; ++m) _Pragma("unroll") for (int k = 0; k < 2; ++k) dst[m][k] = *(const LAS bf16x8*)(lds + PG8_SA(b, h) + aoff + m * 2048 + k * 1024); } while (0)
#define PG8_LDB(dst, b, h) do { _Pragma("unroll") for (int n = 0; n < 2; ++n) _Pragma("unroll") for (int k = 0; k < 2; ++k) dst[n][k] = *(const LAS bf16x8*)(lds + PG8_SB(b, h) + boff + n * 2048 + k * 1024); } while (0)
#define PG8_MMA(ai, bj, At, Bt) do { __builtin_amdgcn_s_setprio(1); _Pragma("unroll") for (int m = 0; m < 4; ++m) _Pragma("unroll") for (int n = 0; n < 2; ++n) _Pragma("unroll") for (int k = 0; k < 2; ++k) \
        acc[ai][bj][m][n] = __builtin_amdgcn_mfma_f32_16x16x32_bf16(Bt[n][k], At[m][k], acc[ai][bj][m][n], 0, 0, 0); __builtin_amdgcn_s_setprio(0); } while (0)
#define PG8_WAIT_V(n) asm volatile("s_waitcnt vmcnt(" #n ")" ::: "memory")
#define PG8_WAIT_L(n) asm volatile("s_waitcnt lgkmcnt(" #n ")" ::: "memory")
#define PG8_BAR __builtin_amdgcn_s_barrier()
#define PG8_SCHED __builtin_amdgcn_sched_barrier(0)
    Unit cur, nxt; int ui = 0;
    if (!S.next(0, cur)) return;
    f32x4 acc[2][2][4][2];
#pragma unroll
    for (int a = 0; a < 2; ++a)
#pragma unroll
        for (int b = 0; b < 2; ++b)
#pragma unroll
            for (int m = 0; m < 4; ++m)
#pragma unroll
                for (int n = 0; n < 2; ++n) acc[a][b][m][n] = (f32x4){0.f, 0.f, 0.f, 0.f};
    bf16x8 At[4][2], B0[2][2], B1[2][2];
    const char* cA = (const char*)g.A + (size_t)cur.g * g.sA * 2 + (size_t)cur.pm * tstepA; const char* cB = (const char*)g.Bt + (size_t)cur.g * g.sB * 2 + (size_t)cur.pn * tstepB;
    PG8_STAGE(PG8_SB(0, 0), cB, voffB); PG8_STAGE(PG8_SA(0, 0), cA, voffA); PG8_STAGE(PG8_SB(0, 1), cB + hstepB, voffB); PG8_STAGE(PG8_SA(0, 1), cA + hstepA, voffA);
    if (wr == 1) PG8_BAR;
    PG8_WAIT_V(4); PG8_BAR;
    PG8_STAGE(PG8_SB(1, 0), cB + kstep, voffB); PG8_STAGE(PG8_SA(1, 0), cA + kstep, voffA); PG8_STAGE(PG8_SB(1, 1), cB + hstepB + kstep, voffB);
    PG8_WAIT_V(6); PG8_BAR;
    for (;;) {
        const bool has_next = S.next(ui + 1, nxt);
        const char* nA = has_next ? (const char*)g.A + (size_t)nxt.g * g.sA * 2 + (size_t)nxt.pm * tstepA : cA;
        const char* nB = has_next ? (const char*)g.Bt + (size_t)nxt.g * g.sB * 2 + (size_t)nxt.pn * tstepB : cB;
        for (int t = 0; t < nt; t += 2) {
            const bool last = (t == nt - 2);
            const char* a1 = cA + (size_t)(t + 1) * kstep;
            const char* a2 = last ? nA : cA + (size_t)(t + 2) * kstep; const char* b2 = last ? nB : cB + (size_t)(t + 2) * kstep;
            const char* a3 = a2 + kstep; const char* b3 = b2 + kstep;
            PG8_LDB(B0, 0, 0); PG8_SCHED; PG8_LDA(At, 0, 0); PG8_STAGE(PG8_SA(1, 1), a1 + hstepA, voffA);
            PG8_WAIT_L(8); PG8_BAR; PG8_WAIT_L(0); PG8_MMA(0, 0, At, B0); PG8_BAR; PG8_SCHED;
            PG8_LDB(B1, 0, 1); PG8_STAGE(PG8_SB(0, 0), b2, voffB);
            PG8_BAR; PG8_WAIT_L(0); PG8_MMA(0, 1, At, B1); PG8_BAR;
            PG8_LDA(At, 0, 1); PG8_STAGE(PG8_SA(0, 0), a2, voffA);
            PG8_BAR; PG8_WAIT_L(0); PG8_MMA(1, 0, At, B0); PG8_BAR; PG8_SCHED;
            PG8_STAGE(PG8_SB(0, 1), b2 + hstepB, voffB);
            PG8_WAIT_V(6); PG8_BAR; PG8_MMA(1, 1, At, B1); PG8_BAR;
            PG8_LDB(B0, 1, 0); PG8_SCHED; PG8_LDA(At, 1, 0); PG8_STAGE(PG8_SA(0, 1), a2 + hstepA, voffA);
            PG8_WAIT_L(8); PG8_BAR; PG8_WAIT_L(0); PG8_MMA(0, 0, At, B0); PG8_BAR; PG8_SCHED;
            PG8_LDB(B1, 1, 1); PG8_STAGE(PG8_SB(1, 0), b3, voffB);
            PG8_BAR; PG8_WAIT_L(0); PG8_MMA(0, 1, At, B1); PG8_BAR;
            PG8_LDA(At, 1, 1); PG8_STAGE(PG8_SA(1, 0), a3, voffA);
            PG8_BAR; PG8_WAIT_L(0); PG8_MMA(1, 0, At, B0); PG8_BAR; PG8_SCHED;
            PG8_STAGE(PG8_SB(1, 1), b3 + hstepB, voffB);
            PG8_WAIT_V(6); PG8_BAR; PG8_MMA(1, 1, At, B1); PG8_BAR;
        }
        E(acc, cur, wr, wc, fr, fq);
        if (!has_next) break;
#pragma unroll
        for (int a = 0; a < 2; ++a)
#pragma unroll
            for (int b = 0; b < 2; ++b)
#pragma unroll
                for (int m = 0; m < 4; ++m)
#pragma unroll
                    for (int n = 0; n < 2; ++n) acc[a][b][m][n] = (f32x4){0.f, 0.f, 0.f, 0.f};
        cur = nxt; cA = nA; cB = nB; ++ui;
    }
    PG8_WAIT_V(0);
    if (wr == 0) PG8_BAR;
    PG8_BAR;
#undef PG8_SA
#undef PG8_SB
#undef PG8_STAGE
#undef PG8_LDA
#undef PG8_LDB
#undef PG8_MMA
#undef PG8_WAIT_V
#undef PG8_WAIT_L
#undef PG8_BAR
#undef PG8_SCHED
}

#define EPI_ROWS_BEGIN  _Pragma("unroll") for (int ai = 0; ai < 2; ++ai) _Pragma("unroll") for (int m = 0; m < 4; ++m) { const int row = row0 + ai * HALF + m * 16;
#define EPI_ROWS_END asm volatile("" ::: "memory"); }
#define EPI_ROWS_END2 if (m & 1) asm volatile("" ::: "memory"); }
typedef const f32x4 (&AccRef)[2][2][4][2];

struct EpiWin {
    static constexpr bool PERM = true; bf16_t* UG; bf16_t* ZVG;
    __device__ __forceinline__ void operator()(AccRef acc, const Unit& u, int wr, int wc, int fr, int fq) const {
        const int row0 = u.pm * BM + wr * 64 + fr, colb = u.pn * BM + wc * 32 + 8 * fq;
        EPI_ROWS_BEGIN
#pragma unroll
            for (int bj = 0; bj < 2; ++bj) { const int col = colb + bj * HALF; const f32x4 v0 = acc[ai][bj][m][0], v1 = acc[ai][bj][m][1];
                u32x4 w; w.x = cvt_pk_bf16(v0[0], v0[1]); w.y = cvt_pk_bf16(v0[2], v0[3]); w.z = cvt_pk_bf16(v1[0], v1[1]); w.w = cvt_pk_bf16(v1[2], v1[3]);
                if (col < 512) { const int chunk = row >> 5, tau = row & 31, gg = col >> 4, h0 = col & 15;
                    *(u32x4*)(UG + ((size_t)(gg * UGR + chunk) * UGK + tau * 16 + h0)) = w; }
                else if (row < L) { *(u32x4*)(ZVG + (size_t)row * 1024 + (col - 512)) = w; } }
        EPI_ROWS_END
    }
};
struct EpiF32Store {
    static constexpr bool PERM = false; float* C; int ldc; size_t sC;
    __device__ __forceinline__ void operator()(AccRef acc, const Unit& u, int wr, int wc, int fr, int fq) const {
        const int row0 = u.pm * BM + wr * 64 + fr, col0 = u.pn * BM + wc * 32 + 4 * fq; float* Cb = C + (size_t)u.g * sC;
        EPI_ROWS_BEGIN
#pragma unroll
            for (int bj = 0; bj < 2; ++bj)
#pragma unroll
                for (int n = 0; n < 2; ++n) *(f32x4*)(Cb + (size_t)row * ldc + col0 + bj * HALF + n * 16) = acc[ai][bj][m][n];
        EPI_ROWS_END
    }
};
struct EpiY {
    static constexpr bool PERM = true; bf16_t* YA;
    __device__ __forceinline__ void operator()(AccRef acc, const Unit& u, int wr, int wc, int fr, int fq) const {
        const int row0 = u.pm * BM + wr * 64 + fr, colb = u.pn * BM + wc * 32 + 8 * fq;
        EPI_ROWS_BEGIN
#pragma unroll
            for (int bj = 0; bj < 2; ++bj) { const int col = colb + bj * HALF; const f32x4 v0 = acc[ai][bj][m][0], v1 = acc[ai][bj][m][1];
                u32x4 w; w.x = cvt_pk_bf16(gelu_tanh(v0[0]), gelu_tanh(v0[1])); w.y = cvt_pk_bf16(gelu_tanh(v0[2]), gelu_tanh(v0[3]));
                w.z = cvt_pk_bf16(gelu_tanh(v1[0]), gelu_tanh(v1[1])); w.w = cvt_pk_bf16(gelu_tanh(v1[2]), gelu_tanh(v1[3]));
                const int tau = col >> 4, h0 = col & 15; const size_t t = (size_t)row * TCH + tau;
                *(u32x4*)(YA + t * 512 + u.g * 16 + h0) = w; }
        EPI_ROWS_END
    }
};
struct EpiGlu {
    static constexpr bool PERM = true; const bf16_t* YA; bf16_t* A1;
    __device__ __forceinline__ void operator()(AccRef acc, const Unit& u, int wr, int wc, int fr, int fq) const {
        const int row0 = u.pm * BM + wr * 64 + fr, colb = u.pn * BM + wc * 32 + 8 * fq;
        EPI_ROWS_BEGIN
#pragma unroll
            for (int bj = 0; bj < 2; ++bj) { const int col = colb + bj * HALF; const f32x4 v0 = acc[ai][bj][m][0], v1 = acc[ai][bj][m][1];
                const u32x4 y = *(const u32x4*)(YA + (size_t)row * 512 + col);
                u32x4 w; w.x = cvt_pk_bf16(bf_lo(y.x) * sigmoidf_(v0[0]), bf_hi(y.x) * sigmoidf_(v0[1])); w.y = cvt_pk_bf16(bf_lo(y.y) * sigmoidf_(v0[2]), bf_hi(y.y) * sigmoidf_(v0[3]));
                w.z = cvt_pk_bf16(bf_lo(y.z) * sigmoidf_(v1[0]), bf_hi(y.z) * sigmoidf_(v1[1])); w.w = cvt_pk_bf16(bf_lo(y.w) * sigmoidf_(v1[2]), bf_hi(y.w) * sigmoidf_(v1[3]));
                *(u32x4*)(A1 + (size_t)row * 1024 + col) = w; }
        EPI_ROWS_END
    }
};
struct EpiWout {
    static constexpr bool PERM = true; const float* x; const float* PR; const float* PC; const float* g1; float* H; bf16_t* HB; float* SSP;
    __device__ __forceinline__ void operator()(AccRef acc, const Unit& u, int wr, int wc, int fr, int fq) const {
        const int row0 = u.pm * BM + wr * 64 + fr, colb = u.pn * BM + wc * 32 + 8 * fq;
        f32x4 gq[2][2];
#pragma unroll
        for (int bj = 0; bj < 2; ++bj) { gq[bj][0] = *(const f32x4*)(g1 + colb + bj * HALF); gq[bj][1] = *(const f32x4*)(g1 + colb + bj * HALF + 4); }
        EPI_ROWS_BEGIN float ssq = 0.f;
#pragma unroll
            for (int bj = 0; bj < 2; ++bj) { const int col = colb + bj * HALF;
                const float* xp = x + (size_t)row * D + col; const float* pp = col < 512 ? PR + (size_t)(row >> 6) * 512 + col : PC + (size_t)(row & 63) * 512 + (col - 512);
                const f32x4 h0 = *(const f32x4*)xp + *(const f32x4*)pp + gq[bj][0] * acc[ai][bj][m][0];
                const f32x4 h1 = *(const f32x4*)(xp + 4) + *(const f32x4*)(pp + 4) + gq[bj][1] * acc[ai][bj][m][1];
                float* hp = H + (size_t)row * D + col; *(f32x4*)hp = h0; *(f32x4*)(hp + 4) = h1;
                u32x4 hb; hb.x = cvt_pk_bf16(h0[0], h0[1]); hb.y = cvt_pk_bf16(h0[2], h0[3]); hb.z = cvt_pk_bf16(h1[0], h1[1]); hb.w = cvt_pk_bf16(h1[2], h1[3]);
                *(u32x4*)(HB + (size_t)row * D + col) = hb;
                ssq += ((h0[0] * h0[0] + h0[1] * h0[1]) + (h0[2] * h0[2] + h0[3] * h0[3])) + ((h1[0] * h1[0] + h1[1] * h1[1]) + (h1[2] * h1[2] + h1[3] * h1[3])); }
            ssq += __shfl_xor(ssq, 16); ssq += __shfl_xor(ssq, 32);
            if (fq == 0) SSP[(size_t)row * 16 + u.pn * 4 + wc] = ssq;
        EPI_ROWS_END2
    }
};
struct EpiMlp1 {
    static constexpr bool PERM = true; bf16_t* HD; const float* SS; const float* B1;
    __device__ __forceinline__ void operator()(AccRef acc, const Unit& u, int wr, int wc, int fr, int fq) const {
        const int row0 = u.pm * BM + wr * 64 + fr, colb = u.pn * BM + wc * 32 + 8 * fq;
        f32x4 cb[2][2]; float rs[8];
#pragma unroll
        for (int bj = 0; bj < 2; ++bj) { cb[bj][0] = *(const f32x4*)(B1 + colb + bj * HALF); cb[bj][1] = *(const f32x4*)(B1 + colb + bj * HALF + 4); }
#pragma unroll
        for (int q = 0; q < 8; ++q) { const int row = row0 + (q >> 2) * HALF + (q & 3) * 16; const f32x4* sp = (const f32x4*)(SS + (size_t)row * 16);
            const f32x4 sq = (sp[0] + sp[1]) + (sp[2] + sp[3]); rs[q] = rsqrtf(((sq[0] + sq[1]) + (sq[2] + sq[3])) * (1.0f / D) + 1e-6f); }
        EPI_ROWS_BEGIN const float rsr = rs[ai * 4 + m];
#pragma unroll
            for (int bj = 0; bj < 2; ++bj) { const int col = colb + bj * HALF;
                f32x4 v0 = acc[ai][bj][m][0] * rsr + cb[bj][0], v1 = acc[ai][bj][m][1] * rsr + cb[bj][1];
#pragma unroll
                for (int j = 0; j < 4; ++j) { const float a = fmaxf(v0[j], 0.f), b = fmaxf(v1[j], 0.f); v0[j] = a * a; v1[j] = b * b; }
                u32x4 w; w.x = cvt_pk_bf16(v0[0], v0[1]); w.y = cvt_pk_bf16(v0[2], v0[3]); w.z = cvt_pk_bf16(v1[0], v1[1]); w.w = cvt_pk_bf16(v1[2], v1[3]);
                *(u32x4*)(HD + (size_t)row * DFF + col) = w; }
        EPI_ROWS_END
    }
};
struct EpiMlp2 {
    static constexpr bool PERM = true; const float* g2; float* H;
    __device__ __forceinline__ void operator()(AccRef acc, const Unit& u, int wr, int wc, int fr, int fq) const {
        const int row0 = u.pm * BM + wr * 64 + fr, colb = u.pn * BM + wc * 32 + 8 * fq;
        f32x4 gq[2][2];
#pragma unroll
        for (int bj = 0; bj < 2; ++bj) { gq[bj][0] = *(const f32x4*)(g2 + colb + bj * HALF); gq[bj][1] = *(const f32x4*)(g2 + colb + bj * HALF + 4); }
        EPI_ROWS_BEGIN
#pragma unroll
            for (int bj = 0; bj < 2; ++bj) { const int col = colb + bj * HALF; float* hp = H + (size_t)row * D + col;
                *(f32x4*)hp = *(const f32x4*)hp + gq[bj][0] * acc[ai][bj][m][0];
                *(f32x4*)(hp + 4) = *(const f32x4*)(hp + 4) + gq[bj][1] * acc[ai][bj][m][1]; }
        EPI_ROWS_END2
    }
};
struct EpiPool {
    static constexpr bool PERM = true; const float* g1; const float* pb; const float* ps; float* H; bf16_t* HB; float* SSP;
    __device__ __forceinline__ void operator()(AccRef acc, const Unit& u, int wr, int wc, int fr, int fq) const {
        const int row0 = u.pm * BM + wr * 64 + fr, colb = u.g * 256 + wc * 32 + 8 * fq;
        f32x4 gs[2][2], gb[2][2];
#pragma unroll
        for (int bj = 0; bj < 2; ++bj)
#pragma unroll
            for (int q = 0; q < 2; ++q) { const int c = colb + bj * HALF + 4 * q; const f32x4 g = *(const f32x4*)(g1 + c), sc = *(const f32x4*)(ps + c); gs[bj][q] = g * sc; gb[bj][q] = gs[bj][q] * *(const f32x4*)(pb + c); }
        EPI_ROWS_BEGIN float ssq = 0.f;
#pragma unroll
            for (int bj = 0; bj < 2; ++bj) { const int col = colb + bj * HALF; float* hp = H + (size_t)row * D + col;
                const f32x4 h0 = *(const f32x4*)hp + (gs[bj][0] * acc[ai][bj][m][0] + gb[bj][0]);
                const f32x4 h1 = *(const f32x4*)(hp + 4) + (gs[bj][1] * acc[ai][bj][m][1] + gb[bj][1]);
                *(f32x4*)hp = h0; *(f32x4*)(hp + 4) = h1;
                u32x4 hb; hb.x = cvt_pk_bf16(h0[0], h0[1]); hb.y = cvt_pk_bf16(h0[2], h0[3]); hb.z = cvt_pk_bf16(h1[0], h1[1]); hb.w = cvt_pk_bf16(h1[2], h1[3]);
                *(u32x4*)(HB + (size_t)row * D + col) = hb;
                ssq += ((h0[0] * h0[0] + h0[1] * h0[1]) + (h0[2] * h0[2] + h0[3] * h0[3])) + ((h1[0] * h1[0] + h1[1] * h1[1]) + (h1[2] * h1[2] + h1[3] * h1[3])); }
            ssq += __shfl_xor(ssq, 16); ssq += __shfl_xor(ssq, 32);
            if (fq == 0) SSP[(size_t)row * 16 + u.g * 4 + wc] = ssq;
        EPI_ROWS_END2
    }
};

#define XB_TMO      128
#define XB_XCNT(j)  (256  + 64 * (j))
#define XB_XSUB(j)  (1280 + 64 * (j))
#define XB_XGEN(j)  (2304 + 64 * (j))
#define XB_TOP      3328
#define XB_TOPGEN   3392
#define XCD_BAR_WORDS 3456
#define XB_SPIN_CAP (1u << 22)
__device__ __forceinline__ unsigned xb_ld(unsigned* p)              { return __hip_atomic_load(p, __ATOMIC_RELAXED, __HIP_MEMORY_SCOPE_AGENT); }
__device__ __forceinline__ unsigned xb_add(unsigned* p, unsigned v) { return __hip_atomic_fetch_add(p, v, __ATOMIC_RELAXED, __HIP_MEMORY_SCOPE_AGENT); }
__device__ __forceinline__ unsigned xb_xcc_id() { return (unsigned)__builtin_amdgcn_s_getreg((3 << 11) | 20) & 0xFu; }
#define XB_SPIN(cond, bar) do { unsigned _sp = 0; while (cond) { __builtin_amdgcn_s_sleep(1); \
    if ((++_sp & 255u) == 0u) { if (xb_ld(&(bar)[XB_TMO])) break; if (_sp > XB_SPIN_CAP) { atomicAdd(&(bar)[XB_TMO], 1u); break; } } } } while (0)
struct XcdBarrier { unsigned* bar; unsigned x; volatile LAS unsigned* st; };
__device__ __forceinline__ XcdBarrier xcd_barrier_post(unsigned* bar, volatile LAS unsigned* st) {
    XcdBarrier b; b.bar = bar; b.x = (unsigned)__builtin_amdgcn_readfirstlane((int)xb_xcc_id()); b.st = st;
    if (threadIdx.x == 0) (void)xb_add(&bar[XB_XCNT(b.x)], 1u);
    return b;
}
__device__ __forceinline__ void xcd_barrier_complete(unsigned* bar, unsigned x, unsigned& nloc, unsigned& nx) {
    const unsigned G = gridDim.x * gridDim.y * gridDim.z;
    unsigned sum, cnt, mine, sp = 0u;
    for (;;) {
        sum = 0u; cnt = 0u; mine = 0u;
#pragma unroll
        for (unsigned j = 0; j < 16; ++j) { const unsigned c = xb_ld(&bar[XB_XCNT(j)]); sum += c; cnt += (c > 0u) ? 1u : 0u; mine = (j == x) ? c : mine; }
        if (sum == G) break;
        __builtin_amdgcn_s_sleep(1);
        if ((++sp & 255u) == 0u) { if (xb_ld(&bar[XB_TMO])) break; if (sp > XB_SPIN_CAP) { atomicAdd(&bar[XB_TMO], 1u); break; } }
    }
    nloc = mine > 0u ? mine : 1u; nx = cnt > 0u ? cnt : 1u;
}
__device__ __forceinline__ void xcd_barrier(const XcdBarrier& b) {
    asm volatile("s_waitcnt vmcnt(0)" ::: "memory");
    __syncthreads();
    if (threadIdx.x == 0) {
        unsigned* bar = b.bar; unsigned bx = b.x; asm volatile("" : "+s"(bar), "+s"(bx));
        __builtin_amdgcn_s_waitcnt(0);
        unsigned nloc = b.st[0], nx = b.st[1];
        if (nloc == 0u) { xcd_barrier_complete(bar, bx, nloc, nx); b.st[0] = nloc; b.st[1] = nx; }
        const unsigned old = xb_add(&bar[XB_XSUB(bx)], 1u);
        const unsigned gen = old / nloc;
        if (old + 1u == (gen + 1u) * nloc) {
            __builtin_amdgcn_fence(__ATOMIC_RELEASE, "agent");
            asm volatile("s_waitcnt vmcnt(0)" ::: "memory");
            const unsigned og = xb_add(&bar[XB_TOP], 1u);
            const unsigned tg = og / nx;
            if (og + 1u == (tg + 1u) * nx) xb_add(&bar[XB_TOPGEN], 1u);
            else XB_SPIN(xb_ld(&bar[XB_TOPGEN]) == tg, bar);
            __builtin_amdgcn_fence(__ATOMIC_ACQUIRE, "agent");
            xb_add(&bar[XB_XGEN(bx)], 1u);
            asm volatile("s_waitcnt vmcnt(0)" ::: "memory");
        } else {
            XB_SPIN(xb_ld(&bar[XB_XGEN(bx)]) == gen, bar);
            __builtin_amdgcn_fence(__ATOMIC_ACQUIRE, "agent");
            asm volatile("s_waitcnt vmcnt(0)" ::: "memory");
        }
    }
    __syncthreads();
}

struct Params {
    const float *x, *c, *ctx, *c_ctx, *w_ada, *b_ada, *norm_mix_g, *norm_mlp_g, *w_in, *w_out;
    const float *lam_re, *lam_im, *log_step, *b_re, *b_im, *c_re, *c_im, *s5_d, *w_glu, *conv_w, *conv_b, *ln_g, *ln_b;
    const float *pool_w, *pool_b, *pool_scale, *mlp_w1, *mlp_w2, *final_g;
    float* out; unsigned char* ws;
    int cg_sync, pad;
};

typedef const Params __attribute__((address_space(4))) CParams;

__device__ __forceinline__ void transpose_item(const float* W, int K, int N, bf16_t* WT, LAS float* scr, int item, int lane, const float* gsg = nullptr, const float* gss = nullptr, const float* shv = nullptr, float* bias = nullptr) {
    const int nblk = N / 32, kb = item / nblk, nb = item % nblk, k0 = 64 * kb, n0 = 32 * nb;
    float tv[32];
#pragma unroll
    for (int i = 0; i < 32; ++i) { const int kk = 2 * i + (lane >> 5); tv[i] = W[(size_t)(k0 + kk) * N + n0 + (lane & 31)]; }
    if (gsg) { float bsum = 0.f;
        const int gsl = __float_as_int(gsg[k0 + lane] * (1.0f + gss[k0 + lane])), shl = __float_as_int(shv[k0 + lane]);
#pragma unroll
        for (int i = 0; i < 32; ++i) { const bool odd = lane >= 32;
            const float gk = __int_as_float(odd ? __builtin_amdgcn_readlane(gsl, 2 * i + 1) : __builtin_amdgcn_readlane(gsl, 2 * i));
            const float sk = __int_as_float(odd ? __builtin_amdgcn_readlane(shl, 2 * i + 1) : __builtin_amdgcn_readlane(shl, 2 * i));
            bsum += sk * tv[i]; tv[i] *= gk; }
        bsum += __shfl_xor(bsum, 32);
        if (lane < 32) atomicAdd(bias + n0 + lane, bsum); }
#pragma unroll
    for (int i = 0; i < 32; ++i) { const int kk = 2 * i + (lane >> 5); scr[kk * 33 + (lane & 31)] = tv[i]; }
    asm volatile("s_waitcnt lgkmcnt(0)" ::: "memory");
    const int c = lane & 7;
#pragma unroll
    for (int j = 0; j < 4; ++j) { const int n = (lane >> 3) + 8 * j; const LAS float* s = scr + (8 * c) * 33 + n;
        u32x4 o; o.x = cvt_pk_bf16(s[0 * 33], s[1 * 33]); o.y = cvt_pk_bf16(s[2 * 33], s[3 * 33]); o.z = cvt_pk_bf16(s[4 * 33], s[5 * 33]); o.w = cvt_pk_bf16(s[6 * 33], s[7 * 33]);
        *(u32x4*)(WT + (size_t)(n0 + n) * K + k0 + 8 * c) = o; }
    asm volatile("s_waitcnt lgkmcnt(0)" ::: "memory");
}

__device__ __forceinline__ void ada_item(CParams& p, LAS unsigned char* lds, int it, int tid, int wave, int lane) {
    LAS float* sc = (LAS float*)lds; LAS float* scc = sc + 1024; LAS float* red = scc + 1024;
    const int l = it / 96, cb = it % 96;
    for (int k = tid; k < 1024; k += NTHR) { const float a = p.c[k], b = p.c_ctx[k]; sc[k] = a / (1.0f + __expf(-a)); scc[k] = b / (1.0f + __expf(-b)); }
    __syncthreads();
    const int col = cb * 64 + lane; const float* W = p.w_ada + (size_t)l * 1024 * 6144 + col;
    float a1 = 0.f, a2 = 0.f; const int k0 = wave * 128;
#pragma unroll 32
    for (int k = 0; k < 128; ++k) { const float w = W[(size_t)(k0 + k) * 6144]; a1 += sc[k0 + k] * w; a2 += scc[k0 + k] * w; }
    red[(wave * 64 + lane) * 2] = a1; red[(wave * 64 + lane) * 2 + 1] = a2;
    __syncthreads();
    if (wave == 0) { float s1 = 0.f, s2 = 0.f;
#pragma unroll
        for (int w = 0; w < 8; ++w) { s1 += red[(w * 64 + lane) * 2]; s2 += red[(w * 64 + lane) * 2 + 1]; }
        const float b = p.b_ada[l * 6144 + col]; float* MOD = (float*)(p.ws + WS_MOD);
        if (l == 0) { MOD[col] = s1 + b; MOD[6144 + col] = s2 + b; } else { MOD[2 * 6144 + col] = s1 + b; } }
    __syncthreads();
}


__device__ __forceinline__ void mlp_transposes(CParams& p, LAS unsigned char* lds, int first, int count, int slot, int nslots, int wave, int lane) {
    LAS float* scr = (LAS float*)(lds + wave * 8704);
    bf16_t* WT_1 = (bf16_t*)(p.ws + WS_W1); bf16_t* WT_2 = (bf16_t*)(p.ws + WS_W2); const float* MOD = (const float*)(p.ws + WS_MOD); float* B1 = (float*)(p.ws + WS_B1);
    for (int it = first + slot; it < first + count; it += nslots) { const int blk = it >> 11, r = it & 2047, l = blk & 1;
        if (blk < 2) transpose_item(p.mlp_w2 + (size_t)l * 4096 * 1024, 4096, 1024, WT_2 + (size_t)l * 1024 * 4096, scr, r, lane);
        else { const float* modl = MOD + (l == 0 ? 0 : 2 * 6144);
            transpose_item(p.mlp_w1 + (size_t)l * 1024 * 4096, 1024, 4096, WT_1 + (size_t)l * 4096 * 1024, scr, r, lane, p.norm_mlp_g + l * D, modl + 4 * 1024, modl + 3 * 1024, B1 + l * DFF); } }
}

constexpr int LPD = 34;
__device__ __forceinline__ void s5_part(CParams& p, LAS unsigned char* lds, int g, int j, int tid) {
    LAS f32x2* LP = (LAS f32x2*)lds;
    LAS f32x2* BB = LP + 64 * LPD;
    LAS f32x2* CM = BB + 64 * 16;
    const int dir = j >> 2, d0 = 8 * (j & 3);
    f32x2* LPG = (f32x2*)(p.ws + WS_LPG) + (size_t)(g * 2 + dir) * 33 * 64;
    f32x2* BBG = (f32x2*)(p.ws + WS_BBG) + (size_t)(g * 2 + dir) * 64 * 16;
    float* KTG = (float*)(p.ws + WS_KTG) + (size_t)(g * 2 + dir) * 32 * 256;
    const bool pub = (j & 3) == 0;
    const float dtf = __expf(p.log_step[dir * 32 + g]);
    for (int idx = tid; idx < 64 * 33; idx += NTHR) { const int pp = idx & 63, d = idx >> 6; const int gi = (dir * 32 + g) * 64 + pp;
        const float a = fminf(p.lam_re[gi], -1e-4f) * dtf, b = p.lam_im[gi] * dtf;
        float sn, cs; sincosf(b * (float)d, &sn, &cs); const float er = expf(a * (float)d);
        const f32x2 z = (f32x2){er * cs, er * sn}; LP[pp * LPD + d] = z;
        if (pub) { LPG[d * 64 + pp] = z; if (d == 32) ((f32x2*)(p.ws + WS_LAMT))[(g * 2 + dir) * 64 + pp] = z; } }
    for (int idx = tid; idx < 64 * 16; idx += NTHR) { const int pp = idx >> 4, h = idx & 15; const int gi = (dir * 32 + g) * 64 + pp;
        const float a = fminf(p.lam_re[gi], -1e-4f) * dtf, b = p.lam_im[gi] * dtf;
        float qr, qi;
        if (a * a + b * b < 0.0625f) { qr = 1.0f; qi = 0.0f;
#pragma unroll
            for (int n = 8; n >= 2; --n) { const float inv = 1.0f / (float)n; const float tr = (a * qr - b * qi) * inv, ti = (a * qi + b * qr) * inv; qr = 1.0f + tr; qi = ti; } }
        else { float sn, cs; sincosf(b, &sn, &cs); const float er = expf(a); const float xr = er * cs - 1.0f, xi = er * sn, den = 1.0f / (a * a + b * b);
            qr = (xr * a + xi * b) * den; qi = (xi * a - xr * b) * den; }
        const float cr = qr * dtf, ci = qi * dtf;
        const float br = p.b_re[(size_t)gi * 16 + h], bi = p.b_im[(size_t)gi * 16 + h];
        const f32x2 bb = (f32x2){cr * br - ci * bi, cr * bi + ci * br}; BB[pp * 16 + h] = bb; if (pub) BBG[pp * 16 + h] = bb; }
    for (int idx = tid; idx < 16 * 64; idx += NTHR) { const int h = idx / 64, pp = idx % 64;
        const size_t gi = ((size_t)(dir * 32 + g) * 16 + h) * 64 + pp;
        CM[h * 65 + pp] = (f32x2){p.c_re[gi], p.c_im[gi]}; }
    __syncthreads();
    { const int dq = tid >> 8, h = (tid >> 4) & 15, hp = tid & 15, db = d0 + 4 * dq;
      float kacc[4] = {0.f, 0.f, 0.f, 0.f};
      for (int pp = 0; pp < 64; ++pp) { const f32x2 cm = CM[h * 65 + pp], bb = BB[pp * 16 + hp];
          const float wr_ = cm.x * bb.x - cm.y * bb.y, wi_ = cm.x * bb.y + cm.y * bb.x;
          const LAS f32x2* lp = LP + pp * LPD + db;
#pragma unroll
          for (int i = 0; i < 4; ++i) { const f32x2 z = lp[i]; kacc[i] += wr_ * z.x - wi_ * z.y; } }
#pragma unroll
      for (int i = 0; i < 4; ++i) KTG[(db + i) * 256 + h * 16 + hp] = kacc[i]; }
    __syncthreads();
}
__device__ __forceinline__ void s5_assemble(CParams& p, int o) {
    const int g = o >> 16, r = o & 65535;
    const f32x2* LPGg = (const f32x2*)(p.ws + WS_LPG) + (size_t)g * 2 * 33 * 64;
    const f32x2* BBGg = (const f32x2*)(p.ws + WS_BBG) + (size_t)g * 2 * 64 * 16;
    const float* KTGg = (const float*)(p.ws + WS_KTG) + (size_t)g * 2 * 32 * 256;
    float v[8]; bf16_t* dst;
    if (r < 512 * 96) { const int n = r / 96, k8 = r % 96, tau = n >> 4, h = n & 15;
        dst = (bf16_t*)(p.ws + WS_MMAT) + (size_t)g * 512 * 768 + (size_t)n * 768 + k8 * 8;
        if (k8 < 64) { const int sg = k8 >> 1, hb = (k8 & 1) * 8;
            f32x4 a0 = (f32x4){0.f, 0.f, 0.f, 0.f}, a1 = a0;
            if (sg <= tau) { const float* kp = KTGg + ((0 * 32 + (tau - sg)) * 16 + h) * 16 + hb; a0 += *(const f32x4*)kp; a1 += *(const f32x4*)(kp + 4); }
            if (sg >= tau) { const float* kp = KTGg + ((1 * 32 + (sg - tau)) * 16 + h) * 16 + hb; a0 += *(const f32x4*)kp; a1 += *(const f32x4*)(kp + 4); }
#pragma unroll
            for (int j = 0; j < 4; ++j) { v[j] = a0[j]; v[4 + j] = a1[j]; }
            if (sg == tau) { const float dsk = p.s5_d[g * 16 + h];
#pragma unroll
                for (int j = 0; j < 8; ++j) if (hb + j == h) v[j] += dsk; }
        } else { const int q = (k8 - 64) * 8, dir = q >> 7, ri = (q >> 6) & 1, pb = q & 63; const int e = dir == 0 ? (tau + 1) : (TCH - tau);
            const size_t ci = ((size_t)(dir * 32 + g) * 16 + h) * 64 + pb;
            const f32x2* zp = LPGg + (dir * 33 + e) * 64 + pb;
#pragma unroll
            for (int j = 0; j < 8; ++j) { const float cr = p.c_re[ci + j], cim = p.c_im[ci + j]; const f32x2 z = zp[j];
                v[j] = ri == 0 ? (cr * z.x - cim * z.y) : -(cr * z.y + cim * z.x); } }
    } else { const int r2 = r - 512 * 96, n = r2 >> 6, k8 = r2 & 63;
        const int dir = n >> 7, ri = (n >> 6) & 1, pp = n & 63, tau = k8 >> 1, hb = (k8 & 1) * 8;
        dst = (bf16_t*)(p.ws + WS_HMAT) + (size_t)g * 256 * 512 + (size_t)n * 512 + k8 * 8;
        const int e = dir == 0 ? (TCH - 1 - tau) : tau; const f32x2 z = LPGg[(dir * 33 + e) * 64 + pp];
        const f32x2* bp = BBGg + (dir * 64 + pp) * 16 + hb;
#pragma unroll
        for (int j = 0; j < 8; ++j) { const f32x2 bb = bp[j]; v[j] = ri == 0 ? (z.x * bb.x - z.y * bb.y) : (z.x * bb.y + z.y * bb.x); } }
    u32x4 ov; ov.x = cvt_pk_bf16(v[0], v[1]); ov.y = cvt_pk_bf16(v[2], v[3]); ov.z = cvt_pk_bf16(v[4], v[5]); ov.w = cvt_pk_bf16(v[6], v[7]);
    *(u32x4*)dst = ov;
}

__device__ __forceinline__ void norm_store(const f32x4 (&v)[4], const float* gvec, const float* shift, const float* scale, bf16_t* orow, int lane) {
    float s = 0.f;
#pragma unroll
    for (int j = 0; j < 4; ++j) s += (v[j].x * v[j].x + v[j].y * v[j].y) + (v[j].z * v[j].z + v[j].w * v[j].w);
    const float rstd = rsqrtf(wave_sum(s) * (1.0f / D) + 1e-6f);
#pragma unroll
    for (int j = 0; j < 4; ++j) { const int c = 4 * lane + 256 * j;
        const f32x4 gv = *(const f32x4*)(gvec + c), sh = *(const f32x4*)(shift + c), sc = *(const f32x4*)(scale + c);
        const f32x4 y = (v[j] * rstd * gv) * (1.0f + sc) + sh;
        u32x2 w; w.x = cvt_pk_bf16(y.x, y.y); w.y = cvt_pk_bf16(y.z, y.w); *(u32x2*)(orow + c) = w; }
}

#ifndef PH_MASK
#define PH_MASK 0xffffffffu
#endif
#define PH(k) ((PH_MASK >> (k)) & 1u)
#ifndef REP_MASK
#define REP_MASK 0u
#endif
#ifndef EXTRA_SYNCS
#define EXTRA_SYNCS 0
#endif
#define REP(k) ((int)((REP_MASK >> (k)) & 1u) + 1)
__global__ void __launch_bounds__(NTHR, 2) fwd_megakernel(Params p) {
    extern __shared__ __attribute__((aligned(16))) unsigned char lds_raw[];
    LAS unsigned char* lds = (LAS unsigned char*)lds_raw;
    cg::grid_group grid = cg::this_grid();
    const int G = gridDim.x, bid = blockIdx.x, NGW = G * NWAVES;
#define PHASE_IDS int tid = threadIdx.x; asm volatile("" : "+v"(tid)); const int lane = tid & 63, wave = __builtin_amdgcn_readfirstlane(tid >> 6), gw = bid * NWAVES + wave; (void)lane; (void)gw; \
    CParams* pp_ = (CParams*)__builtin_amdgcn_kernarg_segment_ptr(); asm volatile("" : "+s"(pp_)); CParams& p = *pp_; unsigned char* ws = p.ws; \
    bf16_t* WT_in = (bf16_t*)(ws + WS_WIN); bf16_t* WT_out = (bf16_t*)(ws + WS_WOUT); bf16_t* WT_glu = (bf16_t*)(ws + WS_WGLU); bf16_t* WT_1 = (bf16_t*)(ws + WS_W1); bf16_t* WT_2 = (bf16_t*)(ws + WS_W2); bf16_t* WT_pool = (bf16_t*)(ws + WS_WPOOL); float* MOD = (float*)(ws + WS_MOD); float* PR = (float*)(ws + WS_PR); float* PC = (float*)(ws + WS_PC); bf16_t* BUFA = (bf16_t*)(ws + WS_BUFA); float* SLOC = (float*)(ws + WS_SLOC); bf16_t* HB = (bf16_t*)(ws + WS_HB); float* SSQ = (float*)(ws + WS_SSP); float* B1V = (float*)(ws + WS_B1); bf16_t* HD = (bf16_t*)(ws + WS_HD); bf16_t* UG = (bf16_t*)(ws + WS_UG); bf16_t* ZVG = (bf16_t*)(ws + WS_ZVG); bf16_t* YA = (bf16_t*)(ws + WS_YA); bf16_t* MMAT = (bf16_t*)(ws + WS_MMAT); bf16_t* HMAT = (bf16_t*)(ws + WS_HMAT); float* H = p.out; \
    (void)WT_in; (void)WT_out; (void)WT_glu; (void)WT_1; (void)WT_2; (void)WT_pool; (void)MOD; (void)PR; (void)PC; (void)BUFA; (void)SLOC; (void)HB; (void)SSQ; (void)B1V; (void)HD; (void)UG; (void)ZVG; (void)YA; (void)MMAT; (void)HMAT; (void)H;
    unsigned char* ws = p.ws;
    Sched S; S.G = G; S.c = bid;
    unsigned* BAR = (unsigned*)(ws + WS_BAR);
    if (threadIdx.x < 4) ((LAS unsigned*)(lds + LDS_BARST_OFF))[threadIdx.x] = 0u;
    __syncthreads();
    XcdBarrier xbar = xcd_barrier_post(BAR, (volatile LAS unsigned*)(lds + LDS_BARST_OFF));
#define GRID_BAR() xcd_barrier(xbar)

#if PH(0)
    for (int rep_ = 0; rep_ < REP(0); ++rep_) { if (rep_) GRID_BAR(); PHASE_IDS
    for (int it = bid; it < 32; it += G) ada_item(p, lds, it, tid, wave, lane);
    for (int it = bid; it < 256; it += G) s5_part(p, lds, it >> 3, it & 7, tid);
    {
        LAS float* scr = (LAS float*)(lds + wave * 8704);
        constexpr int I_IN = 16 * 48, I_OUT = 16 * 32, I_GLU = 8 * 16, I_1 = 16 * 128, I_2 = 64 * 32, I_P = 4 * 8;
        constexpr int NIT = I_IN + I_OUT + I_GLU + 4 * I_P; (void)I_1; (void)I_2;
        for (int it = gw; it < NIT; it += NGW) { int r = it;
            if (r < I_IN) { transpose_item(p.w_in, 1024, 1536, WT_in, scr, r, lane); continue; } r -= I_IN;
            if (r < I_OUT) { transpose_item(p.w_out, 1024, 1024, WT_out, scr, r, lane); continue; } r -= I_OUT;
            if (r < I_GLU) { transpose_item(p.w_glu, 512, 512, WT_glu, scr, r, lane); continue; } r -= I_GLU;
            { const int gi = r / I_P; transpose_item(p.pool_w + (size_t)gi * 256 * 256, 256, 256, WT_pool + (size_t)gi * 256 * 256, scr, r % I_P, lane); } }
        for (int idx = bid * NTHR + tid; idx < 320 * 512; idx += G * NTHR) { const int pos = idx / 512, cidx = idx % 512, k = cidx & 255;
            const float omega = 1.0f / powf(10000.0f, (float)k / 256.0f); const float posf = pos < 256 ? (float)pos : (float)(pos - 256);
            const float ang = posf * omega; const float v = cidx < 256 ? sinf(ang) : cosf(ang);
            if (pos < 256) PR[pos * 512 + cidx] = v; else PC[(pos - 256) * 512 + cidx] = v; }
    }
    }
#endif
    if (p.cg_sync) grid.sync(); else GRID_BAR();

#if PH(1)
    for (int rep_ = 0; rep_ < REP(1); ++rep_) { if (rep_) GRID_BAR(); PHASE_IDS
    for (int rowb = gw; rowb < MROWS; rowb += 4 * NGW) {
        f32x4 v[4][4];
#pragma unroll
        for (int r = 0; r < 4; ++r) { const int row = rowb + r * NGW;
            if (row < L) { const f32x4* xr = (const f32x4*)(p.x + (size_t)row * D) + lane;
#pragma unroll
                for (int j = 0; j < 4; ++j) v[r][j] = xr[64 * j]; }
            else if (row < MROWS) { const f32x4* xr = (const f32x4*)(p.ctx + (size_t)(row - L) * D) + lane;
#pragma unroll
                for (int j = 0; j < 4; ++j) v[r][j] = xr[64 * j]; } }
#pragma unroll
        for (int r = 0; r < 4; ++r) { const int row = rowb + r * NGW;
            if (row < L) {
#pragma unroll
                for (int j = 0; j < 4; ++j) { const f32x4 pv = j < 2 ? *((const f32x4*)(PR + (size_t)(row >> 6) * 512 + j * 256) + lane) : *((const f32x4*)(PC + (size_t)(row & 63) * 512 + (j - 2) * 256) + lane);
                    v[r][j] += pv; }
                norm_store(v[r], p.norm_mix_g, MOD + 0 * 1024, MOD + 1 * 1024, BUFA + (size_t)row * D, lane); }
            else if (row < MROWS) norm_store(v[r], p.norm_mix_g, MOD + 6144 + 0 * 1024, MOD + 6144 + 1 * 1024, BUFA + (size_t)row * D, lane); }
    }
    }
#endif
    GRID_BAR();

#if PH(2)
    for (int rep_ = 0; rep_ < REP(2); ++rep_) { if (rep_) GRID_BAR(); PHASE_IDS
    { GemmD g{}; g.A = BUFA; g.Bt = WT_in; g.lda = 1024; g.ldb = 1024; g.K = 1024; g.sA = 0; g.sB = 0;
      S.nM = MROWS / 256; S.nN = 6; S.nB = 1; EpiWin E; E.UG = UG; E.ZVG = ZVG; gemm_phase(lds, g, S, E); }
    { int fi = (MROWS / 256) * 6 - G; if (fi < 0 || fi >= G) fi = 0;
      if (bid >= fi) for (int o = (bid - fi) * NTHR + tid; o < 32 * 65536; o += (G - fi) * NTHR) s5_assemble(p, o); }
    }
#endif
    GRID_BAR();

#if PH(3)
    for (int rep_ = 0; rep_ < REP(3); ++rep_) { if (rep_) GRID_BAR(); PHASE_IDS
    { GemmD g{}; g.A = UG; g.Bt = HMAT; g.lda = UGK; g.ldb = 512; g.K = 512; g.sA = (size_t)UGR * UGK; g.sB = (size_t)256 * 512;
      S.nM = 3; S.nN = 1; S.nB = 32; EpiF32Store E; E.C = SLOC; E.ldc = 256; E.sC = (size_t)UGR * 256; for (int grep_ = 0; grep_ < REP(14); ++grep_) { gemm_phase(lds, g, S, E); __syncthreads(); } }
    __syncthreads();
    for (int crep_ = 0; crep_ < REP(13); ++crep_) {   PHASE_IDS
        LAS bf16_t* vbs = (LAS bf16_t*)lds;
        LAS float* outs = (LAS float*)(lds + 62 * 512 * 2);
        const float* cw = p.conv_w;
        for (int it = (G == 256) ? bid : (bid + 160) % G; it < L / 32; it += (G == 256) ? (bid < 96 ? L : 160) : G) { const int t0 = it * 32;
            { u32x4 vv[8], gg[8];
#pragma unroll
              for (int k = 0; k < 8; ++k) { const int idx = tid + k * NTHR, r = idx >> 6, c8 = idx & 63; int t = t0 - 15 + r; t = t < 0 ? 0 : (t > L - 1 ? L - 1 : t);
                  if (idx < 62 * 64) { vv[k] = *(const u32x4*)(ZVG + (size_t)t * 1024 + c8 * 8); gg[k] = *(const u32x4*)(ZVG + (size_t)t * 1024 + 512 + c8 * 8); } }
#pragma unroll
              for (int k = 0; k < 8; ++k) { const int idx = tid + k * NTHR, r = idx >> 6, c8 = idx & 63; const int t = t0 - 15 + r;
                  if (idx < 62 * 64) { u32x4 o = (u32x4){0u, 0u, 0u, 0u};
                      if (t >= 0 && t < L) {
                          o.x = cvt_pk_bf16(bf_lo(vv[k].x) * sigmoidf_(bf_lo(gg[k].x)), bf_hi(vv[k].x) * sigmoidf_(bf_hi(gg[k].x)));
                          o.y = cvt_pk_bf16(bf_lo(vv[k].y) * sigmoidf_(bf_lo(gg[k].y)), bf_hi(vv[k].y) * sigmoidf_(bf_hi(gg[k].y)));
                          o.z = cvt_pk_bf16(bf_lo(vv[k].z) * sigmoidf_(bf_lo(gg[k].z)), bf_hi(vv[k].z) * sigmoidf_(bf_hi(gg[k].z)));
                          o.w = cvt_pk_bf16(bf_lo(vv[k].w) * sigmoidf_(bf_lo(gg[k].w)), bf_hi(vv[k].w) * sigmoidf_(bf_hi(gg[k].w))); }
                      *(LAS u32x4*)(vbs + r * 512 + c8 * 8) = o; } } }
            __syncthreads();
            { const int cp = tid & 255, th = tid >> 8;
              f32x2 a2[16];
#pragma unroll
              for (int o = 0; o < 16; ++o) a2[o] = (f32x2){0.f, 0.f};
              f32x2 wv[31];
              const float* cwp = cw + 2 * cp; asm volatile("" : "+v"(cwp));
#pragma unroll
              for (int k = 0; k < 31; ++k) wv[k] = *(const f32x2*)(cwp + k * 512);
#pragma unroll
              for (int j = 0; j < 46; ++j) { const unsigned xw = *(const LAS unsigned*)(vbs + (th * 16 + j) * 512 + 2 * cp); const f32x2 x2 = (f32x2){bf_lo(xw), bf_hi(xw)};
#pragma unroll
                  for (int o = 0; o < 16; ++o) { const int k = j - o; if (k >= 0 && k <= 30) a2[o] = __builtin_elementwise_fma(wv[k], x2, a2[o]); } }
              const f32x2 cb = *(const f32x2*)(p.conv_b + 2 * cp);
#pragma unroll
              for (int o = 0; o < 16; ++o) *(LAS f32x2*)(outs + (th * 16 + o) * 512 + 2 * cp) = a2[o] + cb; }
            __syncthreads();
#pragma unroll
            for (int q = 0; q < 4; ++q) { const int to = wave * 4 + q;
                const f32x4 y0 = *(const LAS f32x4*)(outs + to * 512 + lane * 8), y1 = *(const LAS f32x4*)(outs + to * 512 + lane * 8 + 4);
                const float mean = wave_sum((y0.x + y0.y) + (y0.z + y0.w) + (y1.x + y1.y) + (y1.z + y1.w)) * (1.0f / 512.0f);
                const f32x4 d0 = y0 - mean, d1 = y1 - mean;
                const float var = wave_sum((d0.x * d0.x + d0.y * d0.y) + (d0.z * d0.z + d0.w * d0.w) + (d1.x * d1.x + d1.y * d1.y) + (d1.z * d1.z + d1.w * d1.w)) * (1.0f / 512.0f);
                const float rstd = rsqrtf(var + 1e-6f);
                const f32x4 g0 = *(const f32x4*)(p.ln_g + lane * 8), g1 = *(const f32x4*)(p.ln_g + lane * 8 + 4), b0 = *(const f32x4*)(p.ln_b + lane * 8), b1 = *(const f32x4*)(p.ln_b + lane * 8 + 4);
                f32x4 z0 = d0 * rstd * g0 + b0, z1 = d1 * rstd * g1 + b1;
#pragma unroll
                for (int j = 0; j < 4; ++j) { z0[j] = z0[j] * sigmoidf_(z0[j]); z1[j] = z1[j] * sigmoidf_(z1[j]); }
                u32x4 w; w.x = cvt_pk_bf16(z0.x, z0.y); w.y = cvt_pk_bf16(z0.z, z0.w); w.z = cvt_pk_bf16(z1.x, z1.y); w.w = cvt_pk_bf16(z1.z, z1.w);
                *(u32x4*)(BUFA + (size_t)(t0 + to) * 1024 + 512 + lane * 8) = w; }
            __syncthreads();
        }
    }
    }
#endif
    GRID_BAR();

#if PH(4)
    for (int rep_ = 0; rep_ < REP(4); ++rep_) { if (rep_) GRID_BAR(); PHASE_IDS
    if (bid >= 64 && G > 64) { for (int i2 = bid - 64; i2 < 160; i2 += G - 64) ada_item(p, lds, i2 < 64 ? 32 + i2 : 32 + i2, tid, wave, lane); }
    else if (G <= 64) { for (int i2 = bid; i2 < 160; i2 += G) ada_item(p, lds, 32 + i2, tid, wave, lane); }
    if (bid >= 64 && G > 64) mlp_transposes(p, lds, 0, 4096, (bid - 64) * NWAVES + wave, (G - 64) * NWAVES, wave, lane);
    else if (G <= 64) mlp_transposes(p, lds, 0, 4096, gw, NGW, wave, lane);
    for (int it = bid; it < 64; it += G) { const int g = it >> 1, dir = it & 1;
        LAS f32x2* EX = (LAS f32x2*)lds;
        const f32x2 lam = ((const f32x2*)(ws + WS_LAMT))[(g * 2 + dir) * 64 + lane];
        float pr = lam.x, pi = lam.y;
#pragma unroll
        for (int q = 0; q < 6; ++q) { const float nr = pr * pr - pi * pi, ni = 2.0f * pr * pi; pr = nr; pi = ni; }
        const float* sl = SLOC + (size_t)g * UGR * 256 + dir * 128 + lane;
        bf16_t* ug = UG + (size_t)g * UGR * UGK + 512 + dir * 128 + lane;
        const long sstp = dir == 0 ? 256 : -256, ustp = dir == 0 ? UGK : -UGK; const int ch0 = dir == 0 ? wave * 64 : NCH - 1 - wave * 64;
        float sr = 0.f, si = 0.f;
        if (wave == 0) {
            float cr[8], ci[8];
#pragma unroll
            for (int q = 0; q < 8; ++q) { const int ch = dir == 0 ? NCH + q : NCH + 7 - q; cr[q] = sl[(size_t)ch * 256]; ci[q] = sl[(size_t)ch * 256 + 64]; }
#pragma unroll
            for (int q = 0; q < 8; ++q) { const float nr = lam.x * sr - lam.y * si + cr[q], ni = lam.x * si + lam.y * sr + ci[q]; sr = nr; si = ni; } }
        float ir = sr, ii = si;
        { const float* sp = sl + (size_t)ch0 * 256;
#pragma unroll 1
          for (int jb = 0; jb < 4; ++jb) { float br[16], bi[16];
#pragma unroll
              for (int j = 0; j < 16; ++j) { br[j] = sp[(long)j * sstp]; bi[j] = sp[(long)j * sstp + 64]; }
#pragma unroll
              for (int j = 0; j < 16; ++j) { const float nr = lam.x * sr - lam.y * si + br[j], ni = lam.x * si + lam.y * sr + bi[j]; sr = nr; si = ni; }
              sp += 16 * sstp; } }
        EX[wave * 64 + lane] = (f32x2){sr, si};
        __syncthreads();
        if (wave > 0) { f32x2 f = EX[lane];
            for (int j = 1; j < wave; ++j) { const f32x2 e = EX[j * 64 + lane]; const float nr = pr * f.x - pi * f.y + e.x, ni = pr * f.y + pi * f.x + e.y; f.x = nr; f.y = ni; }
            ir = f.x; ii = f.y; }
        sr = ir; si = ii;
        { const float* sp = sl + (size_t)ch0 * 256; bf16_t* up = ug + (size_t)ch0 * UGK;
#pragma unroll 1
          for (int jb = 0; jb < 4; ++jb) { float br[16], bi[16];
#pragma unroll
              for (int j = 0; j < 16; ++j) { br[j] = sp[(long)j * sstp]; bi[j] = sp[(long)j * sstp + 64]; }
#pragma unroll
              for (int j = 0; j < 16; ++j) { const unsigned w = cvt_pk_bf16(sr, si);
                  up[(long)j * ustp] = (bf16_t)(w & 0xffffu); up[(long)j * ustp + 64] = (bf16_t)(w >> 16);
                  const float nr = lam.x * sr - lam.y * si + br[j], ni = lam.x * si + lam.y * sr + bi[j]; sr = nr; si = ni; }
              sp += 16 * sstp; up += 16 * ustp; } }
        __syncthreads();
    }
    }
#endif
    GRID_BAR();

#if PH(5)
    for (int rep_ = 0; rep_ < REP(5); ++rep_) { if (rep_) GRID_BAR(); PHASE_IDS
    { GemmD g{}; g.A = UG; g.Bt = MMAT; g.lda = UGK; g.ldb = 768; g.K = 768; g.sA = (size_t)UGR * UGK; g.sB = (size_t)512 * 768;
      S.nM = 2; S.nN = 2; S.nB = 32; EpiY E; E.YA = YA; gemm_phase(lds, g, S, E); }
    if (bid >= 128 && G > 128) mlp_transposes(p, lds, 4096, 2048, (bid - 128) * NWAVES + wave, (G - 128) * NWAVES, wave, lane);
    else if (G <= 128) { __syncthreads(); mlp_transposes(p, lds, 4096, 2048, gw, NGW, wave, lane); }
    }
#endif
    GRID_BAR();

#if PH(6)
    for (int rep_ = 0; rep_ < REP(6); ++rep_) { if (rep_) GRID_BAR(); PHASE_IDS
    { GemmD g{}; g.A = YA; g.Bt = WT_glu; g.lda = 512; g.ldb = 512; g.K = 512; g.sA = 0; g.sB = 0;
      S.nM = L / 256; S.nN = 2; S.nB = 1; EpiGlu E; E.YA = YA; E.A1 = BUFA; gemm_phase(lds, g, S, E); }
    if (bid >= 128 && G > 128) mlp_transposes(p, lds, 6144, 2048, (bid - 128) * NWAVES + wave, (G - 128) * NWAVES, wave, lane);
    else if (G <= 128) { __syncthreads(); mlp_transposes(p, lds, 6144, 2048, gw, NGW, wave, lane); }
    }
#endif
    GRID_BAR();

#if PH(7)
    for (int rep_ = 0; rep_ < REP(7); ++rep_) { if (rep_) GRID_BAR(); PHASE_IDS
    { GemmD g{}; g.A = BUFA; g.Bt = WT_out; g.lda = 1024; g.ldb = 1024; g.K = 1024; g.sA = 0; g.sB = 0;
      S.nM = L / 256; S.nN = 4; S.nB = 1; EpiWout E; E.x = p.x; E.PR = PR; E.PC = PC; E.g1 = MOD + 2 * 1024; E.H = H; E.HB = HB; E.SSP = SSQ; gemm_phase(lds, g, S, E); }
    }
#endif
    GRID_BAR();

#define mod (MOD + (layer == 0 ? 0 : 2 * 6144))
    { constexpr int layer = 0;
#if PH(11)
    for (int rep_ = 0; rep_ < REP(11); ++rep_) { if (rep_) GRID_BAR(); PHASE_IDS
        { GemmD g{}; g.A = HB; g.Bt = WT_1 + (size_t)layer * 4096 * 1024; g.lda = 1024; g.ldb = 1024; g.K = 1024; g.sA = 0; g.sB = 0;
          S.nM = L / 256; S.nN = 16; S.nB = 1; EpiMlp1 E; E.HD = HD; E.SS = SSQ + (size_t)layer * L * 16; E.B1 = B1V + layer * DFF; gemm_phase(lds, g, S, E); }
    }
#endif
        GRID_BAR();
#if PH(12)
    for (int rep_ = 0; rep_ < REP(12); ++rep_) { if (rep_) GRID_BAR(); PHASE_IDS
        { GemmD g{}; g.A = HD; g.Bt = WT_2 + (size_t)layer * 1024 * 4096; g.lda = 4096; g.ldb = 4096; g.K = 4096; g.sA = 0; g.sB = 0;
          S.nM = L / 256; S.nN = 4; S.nB = 1; EpiMlp2 E; E.g2 = mod + 5 * 1024; E.H = H; gemm_phase(lds, g, S, E); }
    }
#endif
        GRID_BAR();
    }
    { constexpr int layer = 1;
#if PH(8)
    for (int rep_ = 0; rep_ < REP(8); ++rep_) { if (rep_) GRID_BAR(); PHASE_IDS
            LAS bf16_t* ns = (LAS bf16_t*)lds;
            for (int it = bid; it < L / 32; it += G) { const int t0 = it * 32;
                for (int rb = wave; rb < 47; rb += 3 * NWAVES) { f32x4 v[3][4];
#pragma unroll
                    for (int q = 0; q < 3; ++q) { const int r = rb + q * NWAVES; int t = t0 - 8 + r; t = t < 0 ? 0 : (t > L - 1 ? L - 1 : t);
                        if (r < 47) { const f32x4* hr = (const f32x4*)(H + (size_t)t * D) + lane;
#pragma unroll
                            for (int j = 0; j < 4; ++j) v[q][j] = hr[64 * j]; } }
#pragma unroll
                    for (int q = 0; q < 3; ++q) { const int r = rb + q * NWAVES; const int t = t0 - 8 + r;
                        if (r < 47) {
                            if (t >= 0 && t < L) { float s = 0.f;
#pragma unroll
                                for (int j = 0; j < 4; ++j) s += (v[q][j].x * v[q][j].x + v[q][j].y * v[q][j].y) + (v[q][j].z * v[q][j].z + v[q][j].w * v[q][j].w);
                                const float rstd = rsqrtf(wave_sum(s) * (1.0f / D) + 1e-6f);
#pragma unroll
                                for (int j = 0; j < 4; ++j) { const int c = 4 * lane + 256 * j;
                                    const f32x4 gv = *(const f32x4*)(p.norm_mix_g + D + c), sh = *(const f32x4*)(mod + c), sc = *(const f32x4*)(mod + 1024 + c);
                                    const f32x4 y = (v[q][j] * rstd * gv) * (1.0f + sc) + sh;
                                    u32x2 w; w.x = cvt_pk_bf16(y.x, y.y); w.y = cvt_pk_bf16(y.z, y.w); *(LAS u32x2*)(ns + r * 1024 + c) = w; }
                            } else {
#pragma unroll
                                for (int j = 0; j < 4; ++j) *(LAS u32x2*)(ns + r * 1024 + 4 * lane + 256 * j) = (u32x2){0u, 0u}; } } } }
                __syncthreads();
                { const int gi = tid >> 7, win = 2 << gi, left = win >> 1, right = win - 1 - left;
                  float s0 = 0.f, s1 = 0.f;
                  for (int r = 8 - left; r <= 8 + right; ++r) { const unsigned w = *(const LAS unsigned*)(ns + r * 1024 + 2 * tid); s0 += bf_lo(w); s1 += bf_hi(w); }
                  for (int to = 0; to < 32; ++to) { const int t = t0 + to;
                      if (to > 0) { const unsigned wn = *(const LAS unsigned*)(ns + (to + 8 + right) * 1024 + 2 * tid), wo = *(const LAS unsigned*)(ns + (to + 7 - left) * 1024 + 2 * tid);
                          s0 += bf_lo(wn) - bf_lo(wo); s1 += bf_hi(wn) - bf_hi(wo); }
                      const unsigned ws_ = *(const LAS unsigned*)(ns + (to + 8) * 1024 + 2 * tid);
                      const int lo = max(t - left, 0), hi = min(t + right, L - 1); const float inv = 1.0f / (float)(hi - lo + 1);
                      *(unsigned*)(BUFA + (size_t)t * 1024 + 2 * tid) = cvt_pk_bf16(s0 * inv - bf_lo(ws_), s1 * inv - bf_hi(ws_)); } }
                __syncthreads();
            }
    }
#endif
            GRID_BAR();
#if PH(9)
    for (int rep_ = 0; rep_ < REP(9); ++rep_) { if (rep_) GRID_BAR(); PHASE_IDS
            { GemmD g{}; g.A = BUFA; g.Bt = WT_pool; g.lda = 1024; g.ldb = 256; g.K = 256; g.sA = 256; g.sB = (size_t)256 * 256;
              S.nM = L / 256; S.nN = 1; S.nB = 4; EpiPool E; E.g1 = mod + 2 * 1024; E.pb = p.pool_b; E.ps = p.pool_scale; E.H = H; E.HB = HB; E.SSP = SSQ + (size_t)L * 16; gemm_phase(lds, g, S, E); }
    }
#endif
            GRID_BAR();
#if PH(11)
    for (int rep_ = 0; rep_ < REP(11); ++rep_) { if (rep_) GRID_BAR(); PHASE_IDS
        { GemmD g{}; g.A = HB; g.Bt = WT_1 + (size_t)layer * 4096 * 1024; g.lda = 1024; g.ldb = 1024; g.K = 1024; g.sA = 0; g.sB = 0;
          S.nM = L / 256; S.nN = 16; S.nB = 1; EpiMlp1 E; E.HD = HD; E.SS = SSQ + (size_t)layer * L * 16; E.B1 = B1V + layer * DFF; gemm_phase(lds, g, S, E); }
    }
#endif
        GRID_BAR();
#if PH(12)
    for (int rep_ = 0; rep_ < REP(12); ++rep_) { if (rep_) GRID_BAR(); PHASE_IDS
        { GemmD g{}; g.A = HD; g.Bt = WT_2 + (size_t)layer * 1024 * 4096; g.lda = 4096; g.ldb = 4096; g.K = 4096; g.sA = 0; g.sB = 0;
          S.nM = L / 256; S.nN = 4; S.nB = 1; EpiMlp2 E; E.g2 = mod + 5 * 1024; E.H = H; gemm_phase(lds, g, S, E); }
    }
#endif
        GRID_BAR();
    }

    for (int es_ = 0; es_ < EXTRA_SYNCS; ++es_) GRID_BAR();
    { PHASE_IDS
    for (int rowb = gw; rowb < L; rowb += 4 * NGW) { f32x4 v[4][4];
#pragma unroll
        for (int r = 0; r < 4; ++r) { const int row = rowb + r * NGW; if (row < L) { const f32x4* hr = (const f32x4*)(H + (size_t)row * D) + lane;
#pragma unroll
            for (int j = 0; j < 4; ++j) v[r][j] = hr[64 * j]; } }
#pragma unroll
        for (int r = 0; r < 4; ++r) { const int row = rowb + r * NGW; if (row < L) { f32x4* hr = (f32x4*)(H + (size_t)row * D) + lane; float s = 0.f;
#pragma unroll
            for (int j = 0; j < 4; ++j) s += (v[r][j].x * v[r][j].x + v[r][j].y * v[r][j].y) + (v[r][j].z * v[r][j].z + v[r][j].w * v[r][j].w);
            const float rstd = rsqrtf(wave_sum(s) * (1.0f / D) + 1e-6f);
#pragma unroll
            for (int j = 0; j < 4; ++j) { const f32x4 gv = *((const f32x4*)p.final_g + lane + 64 * j); hr[64 * j] = v[r][j] * rstd * gv; } } } }
    }
}

extern "C" void kernel_launch(void* const* d_in, const int* in_sizes, int n_in, void* d_out, int out_size, void* d_ws, size_t ws_size, hipStream_t stream) {
    static int grid_blocks = 0;
    if (grid_blocks == 0) {
        int dev = 0, cus = 0, per_cu = 0;
        if (hipGetDevice(&dev) != hipSuccess || hipDeviceGetAttribute(&cus, hipDeviceAttributeMultiprocessorCount, dev) != hipSuccess) { fprintf(stderr, "kernel_launch: device query failed\n"); grid_blocks = -1; return; }
        if (hipFuncSetAttribute((const void*)fwd_megakernel, hipFuncAttributeMaxDynamicSharedMemorySize, LDS_BYTES) != hipSuccess) { fprintf(stderr, "kernel_launch: hipFuncSetAttribute failed\n"); grid_blocks = -1; return; }
        if (hipOccupancyMaxActiveBlocksPerMultiprocessor(&per_cu, (const void*)fwd_megakernel, NTHR, LDS_BYTES) != hipSuccess || per_cu < 1) { fprintf(stderr, "kernel_launch: occupancy query says %d blocks per CU\n", per_cu); (void)hipGetLastError(); }
        if (ws_size < WS_END || n_in != 29 || out_size != L * D) { fprintf(stderr, "kernel_launch: unexpected sizes (ws %zu need %zu, n_in %d, out %d)\n", ws_size, (size_t)WS_END, n_in, out_size); grid_blocks = -1; return; }
        grid_blocks = cus;
    }
    if (grid_blocks < 0) return;
    Params p{};
    const float** f = (const float**)&p;
    for (int i = 0; i < 29; ++i) f[i] = (const float*)d_in[i];
    p.out = (float*)d_out; p.ws = (unsigned char*)d_ws; p.cg_sync = 0; p.pad = 0;
    if (hipMemsetAsync((unsigned char*)d_ws + WS_SS, 0, WS_ACC_BYTES, stream) != hipSuccess) { fprintf(stderr, "kernel_launch: hipMemsetAsync of the accumulators failed\n"); return; }
    if (hipMemsetAsync((unsigned char*)d_ws + WS_BAR, 0, (size_t)XCD_BAR_WORDS_C * 4, stream) != hipSuccess) { fprintf(stderr, "kernel_launch: hipMemsetAsync of the barrier words failed\n"); return; }
    void* args[] = {&p};
    hipError_t e = hipLaunchCooperativeKernel((const void*)fwd_megakernel, dim3(grid_blocks), dim3(NTHR), args, LDS_BYTES, stream);
    if (e != hipSuccess) fprintf(stderr, "cooperative launch failed: %s (grid %d)\n", hipGetErrorString(e), grid_blocks);
}
```

```cpp
#include <hip/hip_runtime.h>
#include <hip/hip_cooperative_groups.h>
#include <cstdio>
namespace cg = cooperative_groups;

#define LAS __attribute__((address_space(3)))
typedef unsigned short bf16_t;
typedef short bf16x8 __attribute__((ext_vector_type(8)));
typedef float f32x4 __attribute__((ext_vector_type(4)));
typedef float f32x2 __attribute__((ext_vector_type(2)));
typedef unsigned u32x4 __attribute__((ext_vector_type(4)));
typedef unsigned u32x2 __attribute__((ext_vector_type(2)));

constexpr int L = 16384, D = 1024, NCTX = 256, MROWS = L + NCTX, DFF = 4096;
constexpr int TCH = 32;
constexpr int NCH = L / TCH;
constexpr int UGR = 768, UGK = 768;
constexpr int NTHR = 512, NWAVES = 8;
constexpr int LDS_BYTES = 136 * 1024;
constexpr int XCD_BAR_WORDS_C = 3456;
constexpr int LDS_BARST_OFF = LDS_BYTES - 16;

constexpr size_t WS_WIN = 0;
constexpr size_t WS_WOUT = WS_WIN + (size_t)1536 * 1024 * 2;
constexpr size_t WS_WGLU = WS_WOUT + (size_t)1024 * 1024 * 2;
constexpr size_t WS_W1 = WS_WGLU + (size_t)512 * 512 * 2;
constexpr size_t WS_W2 = WS_W1 + (size_t)2 * 4096 * 1024 * 2;
constexpr size_t WS_WPOOL = WS_W2 + (size_t)2 * 4096 * 1024 * 2;
constexpr size_t WS_MOD = WS_WPOOL + (size_t)4 * 256 * 256 * 2;
constexpr size_t WS_PR = WS_MOD + (size_t)3 * 6144 * 4;
constexpr size_t WS_PC = WS_PR + (size_t)256 * 512 * 4;
constexpr size_t WS_LAMT = WS_PC + (size_t)64 * 512 * 4;
constexpr size_t WS_LPG = WS_LAMT + (size_t)64 * 64 * 8;
constexpr size_t WS_BBG = WS_LPG + (size_t)64 * 33 * 64 * 8;
constexpr size_t WS_KTG = WS_BBG + (size_t)64 * 64 * 16 * 8;
constexpr size_t WS_SS = WS_KTG + (size_t)64 * 32 * 256 * 4;
constexpr size_t WS_B1 = WS_SS + (size_t)2 * L * 4;
constexpr size_t WS_ACC_BYTES = (size_t)2 * L * 4 + (size_t)2 * DFF * 4;
constexpr size_t WS_SSP = WS_SS + WS_ACC_BYTES;
constexpr size_t WS_BAR = WS_SSP + (size_t)2 * L * 16 * 4;
constexpr size_t WS_BUFA = WS_BAR + (size_t)XCD_BAR_WORDS_C * 4;
constexpr size_t WS_SLOC = WS_BUFA + (size_t)MROWS * 1024 * 2;
constexpr size_t WS_HB = WS_SLOC;
constexpr size_t WS_BIG = WS_SLOC + (size_t)L * 1024 * 2;
static_assert((size_t)32 * UGR * 256 * 4 <= (size_t)L * 1024 * 2, "SLOC must fit in the HB slot");
constexpr size_t WS_HD = WS_BIG;
constexpr size_t WS_UG = WS_BIG;
constexpr size_t WS_ZVG = WS_UG + (size_t)32 * UGR * UGK * 2;
constexpr size_t WS_YA = WS_ZVG + (size_t)L * 1024 * 2;
constexpr size_t WS_MMAT = WS_YA + (size_t)L * 512 * 2;
constexpr size_t WS_HMAT = WS_MMAT + (size_t)32 * 512 * 768 * 2;
constexpr size_t WS_BIG_END_A = WS_HMAT + (size_t)32 * 256 * 512 * 2;
constexpr size_t WS_END = WS_BIG + (size_t)L * DFF * 2;
static_assert(WS_BIG_END_A <= WS_END, "alias region overflow");
static_assert(WS_END <= (size_t)256 * 1024 * 1024, "workspace too large");

__device__ __forceinline__ unsigned cvt_pk_bf16(float lo, float hi) { unsigned r; asm("v_cvt_pk_bf16_f32 %0, %1, %2" : "=v"(r) : "v"(lo), "v"(hi)); return r; }
__device__ __forceinline__ float bf_lo(unsigned w) { return __uint_as_float(w << 16); }
__device__ __forceinline__ float bf_hi(unsigned w) { return __uint_as_float(w & 0xffff0000u); }
__device__ __forceinline__ float wave_sum(float v) {
#pragma unroll
    for (int o = 1; o < 64; o <<= 1) v += __shfl_xor(v, o);
    return v;
}
__device__ __forceinline__ float sigmoidf_(float x) { return __builtin_amdgcn_rcpf(1.0f + __builtin_amdgcn_exp2f(-1.4426950408889634f * x)); }
__device__ __forceinline__ float gelu_tanh(float x) { const float z = 0.7978845608028654f * (x + 0.044715f * x * x * x); return x * __builtin_amdgcn_rcpf(1.0f + __builtin_amdgcn_exp2f(-2.8853900817779268f * z)); }

constexpr int BM = 256, BK = 64, HALF = 128, HTB = HALF * BK * 2, STAGE_BYTES = 8 * HTB, NXCD = 8, WGM = 8;
__device__ __forceinline__ int lds_byte(int r, int c) { const int st = (r >> 4) * 2 + (c >> 5), rr = r & 15, cc = c & 31, ob = rr * 64 + cc * 2; return st * 1024 + (ob ^ (((ob >> 9) & 1) << 5)); }
__device__ __forceinline__ void stage_rc(int b, int& R, int& C) { const int st = b / 1024, sb = b % 1024, swz = sb ^ (((sb >> 9) & 1) << 5); R = (st >> 1) * 16 + swz / 64; C = (st & 1) * 32 + (swz % 64) / 2; }
__device__ __forceinline__ int perm32(int rho) { const int n = rho >> 4, i = rho & 15; return 8 * (i >> 2) + 4 * n + (i & 3); }

struct Unit { int pm, pn, g; };
struct GemmD { const bf16_t* A; const bf16_t* Bt; int lda, ldb, K, pad; size_t sA, sB; };
struct Sched {
    int nM, nN, nB, G, c;
    __device__ __forceinline__ bool next(int i, Unit& u) const {
        const int per = nM * nN, nwg = per * nB;
        const long Lq = (long)i * G + c; if (Lq >= nwg) return false;
        if (nB == 1) {
            int wgid = (int)Lq; { const int q = nwg / NXCD, r = nwg % NXCD, xcd = wgid % NXCD, off = wgid / NXCD; wgid = (xcd < r ? xcd * (q + 1) : r * (q + 1) + (xcd - r) * q) + off; }
            const int nig = WGM * nN, gid = wgid / nig, fm = gid * WGM, gsz = (nM - fm) < WGM ? (nM - fm) : WGM;
            u.pm = fm + ((wgid % nig) % gsz); u.pn = (wgid % nig) / gsz; u.g = 0;
        } else { const int q = (int)Lq; u.g = q / per; const int r = q % per; u.pm = r / nN; u.pn = r % nN; }
        return true;
    }
};

template <class Epi>
__device__ __forceinline__ void gemm_phase(LAS unsigned char* lds, const GemmD g, const Sched& S, const Epi& E) {
    int tid = threadIdx.x; asm volatile("" : "+v"(tid));
    const int wid = __builtin_amdgcn_readfirstlane(tid >> 6), lane = tid & 63, wr = wid >> 2, wc = wid & 3, fr = lane & 15, fq = lane >> 4;
    int K = g.K; asm volatile("" : "+s"(K));
    const int nt = K / BK;
    unsigned voffA[2], voffB[2];
#pragma unroll
    for (int i = 0; i < 2; ++i) { int R, C; stage_rc(tid * 16 + i * 8192, R, C); const int Rb = Epi::PERM ? ((R & ~31) + perm32(R & 31)) : R;
        voffA[i] = (unsigned)(R * g.lda + C) * 2u; voffB[i] = (unsigned)(Rb * g.ldb + C) * 2u; }
    const size_t kstep = (size_t)(BK * 2);
    const size_t hstepA = (size_t)HALF * g.lda * 2, hstepB = (size_t)HALF * g.ldb * 2;
    const size_t tstepA = 2 * hstepA, tstepB = 2 * hstepB;
    const unsigned ldsw = (unsigned)wid * 1024u;
    const int aoff = lds_byte(wr * 64 + fr, fq * 8), boff = lds_byte(wc * 32 + fr, fq * 8);
#define PG8_SA(b, h) (((b) * 2 + (h)) * HTB)
#define PG8_SB(b, h) ((4 + (b) * 2 + (h)) * HTB)
#define PG8_STAGE(bufoff, gbase, voff) do { _Pragma("unroll") for (int _i = 0; _i < 2; ++_i) \
        __builtin_amdgcn_global_load_lds((const unsigned*)((const char*)(gbase) + (voff)[_i]), (LAS unsigned*)(lds + (bufoff) + ldsw + _i * 8192), 16, 0, 0); } while (0)
#define PG8_LDA(dst, b, h) do { _Pragma("unroll") for (int m = 0; m < 4; ++m) _Pragma("unroll") for (int k = 0; k < 2; ++k) dst[m][k] = *(const LAS bf16x8*)(lds + PG8_SA(b, h) + aoff + m * 2048 + k * 1024); } while (0)
#define PG8_LDB(dst, b, h) do { _Pragma("unroll") for (int n = 0; n < 2; ++n) _Pragma("unroll") for (int k = 0; k < 2; ++k) dst[n][k] = *(const LAS bf16x8*)(lds + PG8_SB(b, h) + boff + n * 2048 + k * 1024); } while (0)
#define PG8_MMA(ai, bj, At, Bt) do { __builtin_amdgcn_s_setprio(1); _Pragma("unroll") for (int m = 0; m < 4; ++m) _Pragma("unroll") for (int n = 0; n < 2; ++n) _Pragma("unroll") for (int k = 0; k < 2; ++k) \
        acc[ai][bj][m][n] = __builtin_amdgcn_mfma_f32_16x16x32_bf16(Bt[n][k], At[m][k], acc[ai][bj][m][n], 0, 0, 0); __builtin_amdgcn_s_setprio(0); } while (0)
#define PG8_WAIT_V(n) asm volatile("s_waitcnt vmcnt(" #n ")" ::: "memory")
#define PG8_WAIT_L(n) asm volatile("s_waitcnt lgkmcnt(" #n ")" ::: "memory")
#define PG8_BAR __builtin_amdgcn_s_barrier()
#define PG8_SCHED __builtin_amdgcn_sched_barrier(0)
    Unit cur, nxt; int ui = 0;
    if (!S.next(0, cur)) return;
    f32x4 acc[2][2][4][2];
#pragma unroll
    for (int a = 0; a < 2; ++a)
#pragma unroll
        for (int b = 0; b < 2; ++b)
#pragma unroll
            for (int m = 0; m < 4; ++m)
#pragma unroll
                for (int n = 0; n < 2; ++n) acc[a][b][m][n] = (f32x4){0.f, 0.f, 0.f, 0.f};
    bf16x8 At[4][2], B0[2][2], B1[2][2];
    const char* cA = (const char*)g.A + (size_t)cur.g * g.sA * 2 + (size_t)cur.pm * tstepA; const char* cB = (const char*)g.Bt + (size_t)cur.g * g.sB * 2 + (size_t)cur.pn * tstepB;
    PG8_STAGE(PG8_SB(0, 0), cB, voffB); PG8_STAGE(PG8_SA(0, 0), cA, voffA); PG8_STAGE(PG8_SB(0, 1), cB + hstepB, voffB); PG8_STAGE(PG8_SA(0, 1), cA + hstepA, voffA);
    if (wr == 1) PG8_BAR;
    PG8_WAIT_V(4); PG8_BAR;
    PG8_STAGE(PG8_SB(1, 0), cB + kstep, voffB); PG8_STAGE(PG8_SA(1, 0), cA + kstep, voffA); PG8_STAGE(PG8_SB(1, 1), cB + hstepB + kstep, voffB);
    PG8_WAIT_V(6); PG8_BAR;
    for (;;) {
        const bool has_next = S.next(ui + 1, nxt);
        const char* nA = has_next ? (const char*)g.A + (size_t)nxt.g * g.sA * 2 + (size_t)nxt.pm * tstepA : cA;
        const char* nB = has_next ? (const char*)g.Bt + (size_t)nxt.g * g.sB * 2 + (size_t)nxt.pn * tstepB : cB;
        for (int t = 0; t < nt; t += 2) {
            const bool last = (t == nt - 2);
            const char* a1 = cA + (size_t)(t + 1) * kstep;
            const char* a2 = last ? nA : cA + (size_t)(t + 2) * kstep; const char* b2 = last ? nB : cB + (size_t)(t + 2) * kstep;
            const char* a3 = a2 + kstep; const char* b3 = b2 + kstep;
            PG8_LDB(B0, 0, 0); PG8_SCHED; PG8_LDA(At, 0, 0); PG8_STAGE(PG8_SA(1, 1), a1 + hstepA, voffA);
            PG8_WAIT_L(8); PG8_BAR; PG8_WAIT_L(0); PG8_MMA(0, 0, At, B0); PG8_BAR; PG8_SCHED;
            PG8_LDB(B1, 0, 1); PG8_STAGE(PG8_SB(0, 0), b2, voffB);
            PG8_BAR; PG8_WAIT_L(0); PG8_MMA(0, 1, At, B1); PG8_BAR;
            PG8_LDA(At, 0, 1); PG8_STAGE(PG8_SA(0, 0), a2, voffA);
            PG8_BAR; PG8_WAIT_L(0); PG8_MMA(1, 0, At, B0); PG8_BAR; PG8_SCHED;
            PG8_STAGE(PG8_SB(0, 1), b2 + hstepB, voffB);
            PG8_WAIT_V(6); PG8_BAR; PG8_MMA(1, 1, At, B1); PG8_BAR;
            PG8_LDB(B0, 1, 0); PG8_SCHED; PG8_LDA(At, 1, 0); PG8_STAGE(PG8_SA(0, 1), a2 + hstepA, voffA);
            PG8_WAIT_L(8); PG8_BAR; PG8_WAIT_L(0); PG8_MMA(0, 0, At, B0); PG8_BAR; PG8_SCHED;
            PG8_LDB(B1, 1, 1); PG8_STAGE(PG8_SB(1, 0), b3, voffB);
            PG8_BAR; PG8_WAIT_L(0); PG8_MMA(0, 1, At, B1); PG8_BAR;
            PG8_LDA(At, 1, 1); PG8_STAGE(PG8_SA(1, 0), a3, voffA);
            PG8_BAR; PG8_WAIT_L(0); PG8_MMA(1, 0, At, B0); PG8_BAR; PG8_SCHED;
            PG8_STAGE(PG8_SB(1, 1), b3 + hstepB, voffB);
            PG8_WAIT_V(6); PG8_BAR; PG8_MMA(1, 1, At, B1); PG8_BAR;
        }
        E(acc, cur, wr, wc, fr, fq);
        if (!has_next) break;
#pragma unroll
        for (int a = 0; a < 2; ++a)
#pragma unroll
            for (int b = 0; b < 2; ++b)
#pragma unroll
                for (int m = 0; m < 4; ++m)
#pragma unroll
                    for (int n = 0; n < 2; ++n) acc[a][b][m][n] = (f32x4){0.f, 0.f, 0.f, 0.f};
        cur = nxt; cA = nA; cB = nB; ++ui;
    }
    PG8_WAIT_V(0);
    if (wr == 0) PG8_BAR;
    PG8_BAR;
#undef PG8_SA
#undef PG8_SB
#undef PG8_STAGE
#undef PG8_LDA
#undef PG8_LDB
#undef PG8_MMA
#undef PG8_WAIT_V
#undef PG8_WAIT_L
#undef PG8_BAR
#undef PG8_SCHED
}

#define EPI_ROWS_BEGIN  _Pragma("unroll") for (int ai = 0; ai < 2; ++ai) _Pragma("unroll") for (int m = 0; m < 4; ++m) { const int row = row0 + ai * HALF + m * 16;
#define EPI_ROWS_END asm volatile("" ::: "memory"); }
#define EPI_ROWS_END2 if (m & 1) asm volatile("" ::: "memory"); }
#define EPI_ROWS_END4 if (m == 3) asm volatile("" ::: "memory"); }
typedef const f32x4 (&AccRef)[2][2][4][2];

struct EpiWin {
    static constexpr bool PERM = true; bf16_t* UG; bf16_t* ZVG;
    __device__ __forceinline__ void operator()(AccRef acc, const Unit& u, int wr, int wc, int fr, int fq) const {
        const int row0 = u.pm * BM + wr * 64 + fr, colb = u.pn * BM + wc * 32 + 8 * fq;
        EPI_ROWS_BEGIN
#pragma unroll
            for (int bj = 0; bj < 2; ++bj) { const int col = colb + bj * HALF; const f32x4 v0 = acc[ai][bj][m][0], v1 = acc[ai][bj][m][1];
                u32x4 w; w.x = cvt_pk_bf16(v0[0], v0[1]); w.y = cvt_pk_bf16(v0[2], v0[3]); w.z = cvt_pk_bf16(v1[0], v1[1]); w.w = cvt_pk_bf16(v1[2], v1[3]);
                if (col < 512) { const int chunk = row >> 5, tau = row & 31, gg = col >> 4, h0 = col & 15;
                    *(u32x4*)(UG + ((size_t)(gg * UGR + chunk) * UGK + tau * 16 + h0)) = w; }
                else if (row < L) { *(u32x4*)(ZVG + (size_t)row * 1024 + (col - 512)) = w; } }
        EPI_ROWS_END
    }
};
struct EpiF32Store {
    static constexpr bool PERM = false; float* C; int ldc; size_t sC;
    __device__ __forceinline__ void operator()(AccRef acc, const Unit& u, int wr, int wc, int fr, int fq) const {
        const int row0 = u.pm * BM + wr * 64 + fr, col0 = u.pn * BM + wc * 32 + 4 * fq; float* Cb = C + (size_t)u.g * sC;
        EPI_ROWS_BEGIN
#pragma unroll
            for (int bj = 0; bj < 2; ++bj)
#pragma unroll
                for (int n = 0; n < 2; ++n) *(f32x4*)(Cb + (size_t)row * ldc + col0 + bj * HALF + n * 16) = acc[ai][bj][m][n];
        EPI_ROWS_END
    }
};
struct EpiY {
    static constexpr bool PERM = true; bf16_t* YA;
    __device__ __forceinline__ void operator()(AccRef acc, const Unit& u, int wr, int wc, int fr, int fq) const {
        const int row0 = u.pm * BM + wr * 64 + fr, colb = u.pn * BM + wc * 32 + 8 * fq;
        EPI_ROWS_BEGIN
#pragma unroll
            for (int bj = 0; bj < 2; ++bj) { const int col = colb + bj * HALF; const f32x4 v0 = acc[ai][bj][m][0], v1 = acc[ai][bj][m][1];
                u32x4 w; w.x = cvt_pk_bf16(gelu_tanh(v0[0]), gelu_tanh(v0[1])); w.y = cvt_pk_bf16(gelu_tanh(v0[2]), gelu_tanh(v0[3]));
                w.z = cvt_pk_bf16(gelu_tanh(v1[0]), gelu_tanh(v1[1])); w.w = cvt_pk_bf16(gelu_tanh(v1[2]), gelu_tanh(v1[3]));
                const int tau = col >> 4, h0 = col & 15; const size_t t = (size_t)row * TCH + tau;
                *(u32x4*)(YA + t * 512 + u.g * 16 + h0) = w; }
        EPI_ROWS_END
    }
};
struct EpiGlu {
    static constexpr bool PERM = true; const bf16_t* YA; bf16_t* A1;
    __device__ __forceinline__ void operator()(AccRef acc, const Unit& u, int wr, int wc, int fr, int fq) const {
        const int row0 = u.pm * BM + wr * 64 + fr, colb = u.pn * BM + wc * 32 + 8 * fq;
        EPI_ROWS_BEGIN
#pragma unroll
            for (int bj = 0; bj < 2; ++bj) { const int col = colb + bj * HALF; const f32x4 v0 = acc[ai][bj][m][0], v1 = acc[ai][bj][m][1];
                const u32x4 y = *(const u32x4*)(YA + (size_t)row * 512 + col);
                u32x4 w; w.x = cvt_pk_bf16(bf_lo(y.x) * sigmoidf_(v0[0]), bf_hi(y.x) * sigmoidf_(v0[1])); w.y = cvt_pk_bf16(bf_lo(y.y) * sigmoidf_(v0[2]), bf_hi(y.y) * sigmoidf_(v0[3]));
                w.z = cvt_pk_bf16(bf_lo(y.z) * sigmoidf_(v1[0]), bf_hi(y.z) * sigmoidf_(v1[1])); w.w = cvt_pk_bf16(bf_lo(y.w) * sigmoidf_(v1[2]), bf_hi(y.w) * sigmoidf_(v1[3]));
                *(u32x4*)(A1 + (size_t)row * 1024 + col) = w; }
        EPI_ROWS_END
    }
};
struct EpiWout {
    static constexpr bool PERM = true; const float* x; const float* PR; const float* PC; const float* g1; float* H; bf16_t* HB; float* SSP;
    __device__ __forceinline__ void operator()(AccRef acc, const Unit& u, int wr, int wc, int fr, int fq) const {
        const int row0 = u.pm * BM + wr * 64 + fr, colb = u.pn * BM + wc * 32 + 8 * fq;
        f32x4 gq[2][2];
#pragma unroll
        for (int bj = 0; bj < 2; ++bj) { gq[bj][0] = *(const f32x4*)(g1 + colb + bj * HALF); gq[bj][1] = *(const f32x4*)(g1 + colb + bj * HALF + 4); }
        EPI_ROWS_BEGIN float ssq = 0.f;
#pragma unroll
            for (int bj = 0; bj < 2; ++bj) { const int col = colb + bj * HALF;
                const float* xp = x + (size_t)row * D + col; const float* pp = col < 512 ? PR + (size_t)(row >> 6) * 512 + col : PC + (size_t)(row & 63) * 512 + (col - 512);
                const f32x4 h0 = *(const f32x4*)xp + *(const f32x4*)pp + gq[bj][0] * acc[ai][bj][m][0];
                const f32x4 h1 = *(const f32x4*)(xp + 4) + *(const f32x4*)(pp + 4) + gq[bj][1] * acc[ai][bj][m][1];
                u32x4 hb; hb.x = cvt_pk_bf16(h0[0], h0[1]); hb.y = cvt_pk_bf16(h0[2], h0[3]); hb.z = cvt_pk_bf16(h1[0], h1[1]); hb.w = cvt_pk_bf16(h1[2], h1[3]);
                *(u32x4*)(HB + (size_t)row * D + col) = hb;
                ssq += ((h0[0] * h0[0] + h0[1] * h0[1]) + (h0[2] * h0[2] + h0[3] * h0[3])) + ((h1[0] * h1[0] + h1[1] * h1[1]) + (h1[2] * h1[2] + h1[3] * h1[3])); }
            ssq += __shfl_xor(ssq, 16); ssq += __shfl_xor(ssq, 32);
            if (fq == 0) SSP[(size_t)row * 16 + u.pn * 4 + wc] = ssq;
        EPI_ROWS_END2
    }
};
struct EpiMlp1 {
    static constexpr bool PERM = true; bf16_t* HD; const float* SS; const float* B1;
    __device__ __forceinline__ void operator()(AccRef acc, const Unit& u, int wr, int wc, int fr, int fq) const {
        const int row0 = u.pm * BM + wr * 64 + fr, colb = u.pn * BM + wc * 32 + 8 * fq;
        f32x4 cb[2][2]; float rs[8];
#pragma unroll
        for (int bj = 0; bj < 2; ++bj) { cb[bj][0] = *(const f32x4*)(B1 + colb + bj * HALF); cb[bj][1] = *(const f32x4*)(B1 + colb + bj * HALF + 4); }
#pragma unroll
        for (int q = 0; q < 8; ++q) { const int row = row0 + (q >> 2) * HALF + (q & 3) * 16; const f32x4* sp = (const f32x4*)(SS + (size_t)row * 16);
            const f32x4 sq = (sp[0] + sp[1]) + (sp[2] + sp[3]); rs[q] = rsqrtf(((sq[0] + sq[1]) + (sq[2] + sq[3])) * (1.0f / D) + 1e-6f); }
        EPI_ROWS_BEGIN const float rsr = rs[ai * 4 + m];
#pragma unroll
            for (int bj = 0; bj < 2; ++bj) { const int col = colb + bj * HALF;
                f32x4 v0 = acc[ai][bj][m][0] * rsr + cb[bj][0], v1 = acc[ai][bj][m][1] * rsr + cb[bj][1];
#pragma unroll
                for (int j = 0; j < 4; ++j) { const float a = fmaxf(v0[j], 0.f), b = fmaxf(v1[j], 0.f); v0[j] = a * a; v1[j] = b * b; }
                u32x4 w; w.x = cvt_pk_bf16(v0[0], v0[1]); w.y = cvt_pk_bf16(v0[2], v0[3]); w.z = cvt_pk_bf16(v1[0], v1[1]); w.w = cvt_pk_bf16(v1[2], v1[3]);
                *(u32x4*)(HD + (size_t)row * DFF + col) = w; }
        EPI_ROWS_END
    }
};
template <bool FINAL> struct EpiMlp2 {
    static constexpr bool PERM = true; const float* g2; bf16_t* HB; float* OUT;
    __device__ __forceinline__ void operator()(AccRef acc, const Unit& u, int wr, int wc, int fr, int fq) const {
        const int row0 = u.pm * BM + wr * 64 + fr, colb = u.pn * BM + wc * 32 + 8 * fq;
        f32x4 gq[2][2];
#pragma unroll
        for (int bj = 0; bj < 2; ++bj) { gq[bj][0] = *(const f32x4*)(g2 + colb + bj * HALF); gq[bj][1] = *(const f32x4*)(g2 + colb + bj * HALF + 4); }
        EPI_ROWS_BEGIN
#pragma unroll
            for (int bj = 0; bj < 2; ++bj) { const int col = colb + bj * HALF; bf16_t* hbp = HB + (size_t)row * D + col; const u32x4 r = *(const u32x4*)hbp;
                const f32x4 h0 = (f32x4){bf_lo(r.x), bf_hi(r.x), bf_lo(r.y), bf_hi(r.y)} + gq[bj][0] * acc[ai][bj][m][0];
                const f32x4 h1 = (f32x4){bf_lo(r.z), bf_hi(r.z), bf_lo(r.w), bf_hi(r.w)} + gq[bj][1] * acc[ai][bj][m][1];
                if (FINAL) { float* op = OUT + (size_t)row * D + col; *(f32x4*)op = h0; *(f32x4*)(op + 4) = h1; }
                else { u32x4 hb; hb.x = cvt_pk_bf16(h0[0], h0[1]); hb.y = cvt_pk_bf16(h0[2], h0[3]); hb.z = cvt_pk_bf16(h1[0], h1[1]); hb.w = cvt_pk_bf16(h1[2], h1[3]); *(u32x4*)hbp = hb; } }
        EPI_ROWS_END4
    }
};
struct EpiPool {
    static constexpr bool PERM = true; const float* g1; const float* pb; const float* ps; float* H; bf16_t* HB; float* SSP;
    __device__ __forceinline__ void operator()(AccRef acc, const Unit& u, int wr, int wc, int fr, int fq) const {
        const int row0 = u.pm * BM + wr * 64 + fr, colb = u.g * 256 + wc * 32 + 8 * fq;
        f32x4 gs[2][2], gb[2][2];
#pragma unroll
        for (int bj = 0; bj < 2; ++bj)
#pragma unroll
            for (int q = 0; q < 2; ++q) { const int c = colb + bj * HALF + 4 * q; const f32x4 g = *(const f32x4*)(g1 + c), sc = *(const f32x4*)(ps + c); gs[bj][q] = g * sc; gb[bj][q] = gs[bj][q] * *(const f32x4*)(pb + c); }
        EPI_ROWS_BEGIN float ssq = 0.f;
#pragma unroll
            for (int bj = 0; bj < 2; ++bj) { const int col = colb + bj * HALF; const u32x4 r = *(const u32x4*)(HB + (size_t)row * D + col);
                const f32x4 h0 = (f32x4){bf_lo(r.x), bf_hi(r.x), bf_lo(r.y), bf_hi(r.y)} + (gs[bj][0] * acc[ai][bj][m][0] + gb[bj][0]);
                const f32x4 h1 = (f32x4){bf_lo(r.z), bf_hi(r.z), bf_lo(r.w), bf_hi(r.w)} + (gs[bj][1] * acc[ai][bj][m][1] + gb[bj][1]);
                u32x4 hb; hb.x = cvt_pk_bf16(h0[0], h0[1]); hb.y = cvt_pk_bf16(h0[2], h0[3]); hb.z = cvt_pk_bf16(h1[0], h1[1]); hb.w = cvt_pk_bf16(h1[2], h1[3]);
                *(u32x4*)(HB + (size_t)row * D + col) = hb;
                ssq += ((h0[0] * h0[0] + h0[1] * h0[1]) + (h0[2] * h0[2] + h0[3] * h0[3])) + ((h1[0] * h1[0] + h1[1] * h1[1]) + (h1[2] * h1[2] + h1[3] * h1[3])); }
            ssq += __shfl_xor(ssq, 16); ssq += __shfl_xor(ssq, 32);
            if (fq == 0) SSP[(size_t)row * 16 + u.g * 4 + wc] = ssq;
        EPI_ROWS_END2
    }
};

#define XB_TMO      128
#define XB_XCNT(j)  (256  + 64 * (j))
#define XB_XSUB(j)  (1280 + 64 * (j))
#define XB_XGEN(j)  (2304 + 64 * (j))
#define XB_TOP      3328
#define XB_TOPGEN   3392
#define XCD_BAR_WORDS 3456
#define XB_SPIN_CAP (1u << 22)
__device__ __forceinline__ unsigned xb_ld(unsigned* p)              { return __hip_atomic_load(p, __ATOMIC_RELAXED, __HIP_MEMORY_SCOPE_AGENT); }
__device__ __forceinline__ unsigned xb_add(unsigned* p, unsigned v) { return __hip_atomic_fetch_add(p, v, __ATOMIC_RELAXED, __HIP_MEMORY_SCOPE_AGENT); }
__device__ __forceinline__ unsigned xb_xcc_id() { return (unsigned)__builtin_amdgcn_s_getreg((3 << 11) | 20) & 0xFu; }
#define XB_SPIN(cond, bar) do { unsigned _sp = 0; while (cond) { __builtin_amdgcn_s_sleep(1); \
    if ((++_sp & 255u) == 0u) { if (xb_ld(&(bar)[XB_TMO])) break; if (_sp > XB_SPIN_CAP) { atomicAdd(&(bar)[XB_TMO], 1u); break; } } } } while (0)
struct XcdBarrier { unsigned* bar; unsigned x; volatile LAS unsigned* st; };
__device__ __forceinline__ XcdBarrier xcd_barrier_post(unsigned* bar, volatile LAS unsigned* st) {
    XcdBarrier b; b.bar = bar; b.x = (unsigned)__builtin_amdgcn_readfirstlane((int)xb_xcc_id()); b.st = st;
    if (threadIdx.x == 0) (void)xb_add(&bar[XB_XCNT(b.x)], 1u);
    return b;
}
__device__ __forceinline__ void xcd_barrier_complete(unsigned* bar, unsigned x, unsigned& nloc, unsigned& nx) {
    const unsigned G = gridDim.x * gridDim.y * gridDim.z;
    unsigned sum, cnt, mine, sp = 0u;
    for (;;) {
        sum = 0u; cnt = 0u; mine = 0u;
#pragma unroll
        for (unsigned j = 0; j < 16; ++j) { const unsigned c = xb_ld(&bar[XB_XCNT(j)]); sum += c; cnt += (c > 0u) ? 1u : 0u; mine = (j == x) ? c : mine; }
        if (sum == G) break;
        __builtin_amdgcn_s_sleep(1);
        if ((++sp & 255u) == 0u) { if (xb_ld(&bar[XB_TMO])) break; if (sp > XB_SPIN_CAP) { atomicAdd(&bar[XB_TMO], 1u); break; } }
    }
    nloc = mine > 0u ? mine : 1u; nx = cnt > 0u ? cnt : 1u;
}
__device__ __forceinline__ void xcd_barrier(const XcdBarrier& b) {
    asm volatile("s_waitcnt vmcnt(0)" ::: "memory");
    __syncthreads();
    if (threadIdx.x == 0) {
        unsigned* bar = b.bar; unsigned bx = b.x; asm volatile("" : "+s"(bar), "+s"(bx));
        __builtin_amdgcn_s_waitcnt(0);
        unsigned nloc = b.st[0], nx = b.st[1];
        if (nloc == 0u) { xcd_barrier_complete(bar, bx, nloc, nx); b.st[0] = nloc; b.st[1] = nx; }
        const unsigned old = xb_add(&bar[XB_XSUB(bx)], 1u);
        const unsigned gen = old / nloc;
        if (old + 1u == (gen + 1u) * nloc) {
            __builtin_amdgcn_fence(__ATOMIC_RELEASE, "agent");
            asm volatile("s_waitcnt vmcnt(0)" ::: "memory");
            const unsigned og = xb_add(&bar[XB_TOP], 1u);
            const unsigned tg = og / nx;
            if (og + 1u == (tg + 1u) * nx) xb_add(&bar[XB_TOPGEN], 1u);
            else XB_SPIN(xb_ld(&bar[XB_TOPGEN]) == tg, bar);
            __builtin_amdgcn_fence(__ATOMIC_ACQUIRE, "agent");
            xb_add(&bar[XB_XGEN(bx)], 1u);
            asm volatile("s_waitcnt vmcnt(0)" ::: "memory");
        } else {
            XB_SPIN(xb_ld(&bar[XB_XGEN(bx)]) == gen, bar);
            __builtin_amdgcn_fence(__ATOMIC_ACQUIRE, "agent");
            asm volatile("s_waitcnt vmcnt(0)" ::: "memory");
        }
    }
    __syncthreads();
}

struct Params {
    const float *x, *c, *ctx, *c_ctx, *w_ada, *b_ada, *norm_mix_g, *norm_mlp_g, *w_in, *w_out;
    const float *lam_re, *lam_im, *log_step, *b_re, *b_im, *c_re, *c_im, *s5_d, *w_glu, *conv_w, *conv_b, *ln_g, *ln_b;
    const float *pool_w, *pool_b, *pool_scale, *mlp_w1, *mlp_w2, *final_g;
    float* out; unsigned char* ws;
    int cg_sync, pad;
};

typedef const Params __attribute__((address_space(4))) CParams;

__device__ __forceinline__ void transpose_item(const float* W, int K, int N, bf16_t* WT, LAS float* scr, int item, int lane, const float* gsg = nullptr, const float* gss = nullptr, const float* shv = nullptr, float* bias = nullptr) {
    const int nblk = N / 32, kb = item / nblk, nb = item % nblk, k0 = 64 * kb, n0 = 32 * nb;
    float tv[32];
#pragma unroll
    for (int i = 0; i < 32; ++i) { const int kk = 2 * i + (lane >> 5); tv[i] = W[(size_t)(k0 + kk) * N + n0 + (lane & 31)]; }
    if (gsg) { float bsum = 0.f;
        const int gsl = __float_as_int(gsg[k0 + lane] * (1.0f + gss[k0 + lane])), shl = __float_as_int(shv[k0 + lane]);
#pragma unroll
        for (int i = 0; i < 32; ++i) { const bool odd = lane >= 32;
            const float gk = __int_as_float(odd ? __builtin_amdgcn_readlane(gsl, 2 * i + 1) : __builtin_amdgcn_readlane(gsl, 2 * i));
            const float sk = __int_as_float(odd ? __builtin_amdgcn_readlane(shl, 2 * i + 1) : __builtin_amdgcn_readlane(shl, 2 * i));
            bsum += sk * tv[i]; tv[i] *= gk; }
        bsum += __shfl_xor(bsum, 32);
        if (lane < 32) atomicAdd(bias + n0 + lane, bsum); }
#pragma unroll
    for (int i = 0; i < 32; ++i) { const int kk = 2 * i + (lane >> 5); scr[kk * 33 + (lane & 31)] = tv[i]; }
    asm volatile("s_waitcnt lgkmcnt(0)" ::: "memory");
    const int c = lane & 7;
#pragma unroll
    for (int j = 0; j < 4; ++j) { const int n = (lane >> 3) + 8 * j; const LAS float* s = scr + (8 * c) * 33 + n;
        u32x4 o; o.x = cvt_pk_bf16(s[0 * 33], s[1 * 33]); o.y = cvt_pk_bf16(s[2 * 33], s[3 * 33]); o.z = cvt_pk_bf16(s[4 * 33], s[5 * 33]); o.w = cvt_pk_bf16(s[6 * 33], s[7 * 33]);
        *(u32x4*)(WT + (size_t)(n0 + n) * K + k0 + 8 * c) = o; }
    asm volatile("s_waitcnt lgkmcnt(0)" ::: "memory");
}

__device__ __forceinline__ void ada_item(CParams& p, LAS unsigned char* lds, int it, int tid, int wave, int lane) {
    LAS float* sc = (LAS float*)lds; LAS float* scc = sc + 1024; LAS float* red = scc + 1024;
    const int l = it / 96, cb = it % 96;
    for (int k = tid; k < 1024; k += NTHR) { const float a = p.c[k], b = p.c_ctx[k]; sc[k] = a / (1.0f + __expf(-a)); scc[k] = b / (1.0f + __expf(-b)); }
    __syncthreads();
    const int col = cb * 64 + lane; const float* W = p.w_ada + (size_t)l * 1024 * 6144 + col;
    float a1 = 0.f, a2 = 0.f; const int k0 = wave * 128;
#pragma unroll 32
    for (int k = 0; k < 128; ++k) { const float w = W[(size_t)(k0 + k) * 6144]; a1 += sc[k0 + k] * w; a2 += scc[k0 + k] * w; }
    red[(wave * 64 + lane) * 2] = a1; red[(wave * 64 + lane) * 2 + 1] = a2;
    __syncthreads();
    if (wave == 0) { float s1 = 0.f, s2 = 0.f;
#pragma unroll
        for (int w = 0; w < 8; ++w) { s1 += red[(w * 64 + lane) * 2]; s2 += red[(w * 64 + lane) * 2 + 1]; }
        const float b = p.b_ada[l * 6144 + col]; float* MOD = (float*)(p.ws + WS_MOD);
        if (l == 0) { MOD[col] = s1 + b; MOD[6144 + col] = s2 + b; } else { MOD[2 * 6144 + col] = s1 + b; } }
    __syncthreads();
}


__device__ __forceinline__ void mlp_transposes(CParams& p, LAS unsigned char* lds, int first, int count, int slot, int nslots, int wave, int lane) {
    LAS float* scr = (LAS float*)(lds + wave * 8704);
    bf16_t* WT_1 = (bf16_t*)(p.ws + WS_W1); bf16_t* WT_2 = (bf16_t*)(p.ws + WS_W2); const float* MOD = (const float*)(p.ws + WS_MOD); float* B1 = (float*)(p.ws + WS_B1);
    for (int it = first + slot; it < first + count; it += nslots) { const int blk = it >> 11, r = it & 2047, l = blk & 1;
        if (blk < 2) transpose_item(p.mlp_w2 + (size_t)l * 4096 * 1024, 4096, 1024, WT_2 + (size_t)l * 1024 * 4096, scr, r, lane);
        else { const float* modl = MOD + (l == 0 ? 0 : 2 * 6144);
            transpose_item(p.mlp_w1 + (size_t)l * 1024 * 4096, 1024, 4096, WT_1 + (size_t)l * 4096 * 1024, scr, r, lane, p.norm_mlp_g + l * D, modl + 4 * 1024, modl + 3 * 1024, B1 + l * DFF); } }
}

constexpr int LPD = 34;
__device__ __forceinline__ void s5_part(CParams& p, LAS unsigned char* lds, int g, int j, int tid) {
    LAS f32x2* LP = (LAS f32x2*)lds;
    LAS f32x2* BB = LP + 64 * LPD;
    LAS f32x2* CM = BB + 64 * 16;
    const int dir = j >> 2, d0 = 8 * (j & 3);
    f32x2* LPG = (f32x2*)(p.ws + WS_LPG) + (size_t)(g * 2 + dir) * 33 * 64;
    f32x2* BBG = (f32x2*)(p.ws + WS_BBG) + (size_t)(g * 2 + dir) * 64 * 16;
    float* KTG = (float*)(p.ws + WS_KTG) + (size_t)(g * 2 + dir) * 32 * 256;
    const bool pub = (j & 3) == 0;
    const float dtf = __expf(p.log_step[dir * 32 + g]);
    for (int idx = tid; idx < 64 * 33; idx += NTHR) { const int pp = idx & 63, d = idx >> 6; const int gi = (dir * 32 + g) * 64 + pp;
        const float a = fminf(p.lam_re[gi], -1e-4f) * dtf, b = p.lam_im[gi] * dtf;
        float sn, cs; sincosf(b * (float)d, &sn, &cs); const float er = expf(a * (float)d);
        const f32x2 z = (f32x2){er * cs, er * sn}; LP[pp * LPD + d] = z;
        if (pub) { LPG[d * 64 + pp] = z; if (d == 32) ((f32x2*)(p.ws + WS_LAMT))[(g * 2 + dir) * 64 + pp] = z; } }
    for (int idx = tid; idx < 64 * 16; idx += NTHR) { const int pp = idx >> 4, h = idx & 15; const int gi = (dir * 32 + g) * 64 + pp;
        const float a = fminf(p.lam_re[gi], -1e-4f) * dtf, b = p.lam_im[gi] * dtf;
        float qr, qi;
        if (a * a + b * b < 0.0625f) { qr = 1.0f; qi = 0.0f;
#pragma unroll
            for (int n = 8; n >= 2; --n) { const float inv = 1.0f / (float)n; const float tr = (a * qr - b * qi) * inv, ti = (a * qi + b * qr) * inv; qr = 1.0f + tr; qi = ti; } }
        else { float sn, cs; sincosf(b, &sn, &cs); const float er = expf(a); const float xr = er * cs - 1.0f, xi = er * sn, den = 1.0f / (a * a + b * b);
            qr = (xr * a + xi * b) * den; qi = (xi * a - xr * b) * den; }
        const float cr = qr * dtf, ci = qi * dtf;
        const float br = p.b_re[(size_t)gi * 16 + h], bi = p.b_im[(size_t)gi * 16 + h];
        const f32x2 bb = (f32x2){cr * br - ci * bi, cr * bi + ci * br}; BB[pp * 16 + h] = bb; if (pub) BBG[pp * 16 + h] = bb; }
    for (int idx = tid; idx < 16 * 64; idx += NTHR) { const int h = idx / 64, pp = idx % 64;
        const size_t gi = ((size_t)(dir * 32 + g) * 16 + h) * 64 + pp;
        CM[h * 65 + pp] = (f32x2){p.c_re[gi], p.c_im[gi]}; }
    __syncthreads();
    { const int dq = tid >> 8, h = (tid >> 4) & 15, hp = tid & 15, db = d0 + 4 * dq;
      float kacc[4] = {0.f, 0.f, 0.f, 0.f};
      for (int pp = 0; pp < 64; ++pp) { const f32x2 cm = CM[h * 65 + pp], bb = BB[pp * 16 + hp];
          const float wr_ = cm.x * bb.x - cm.y * bb.y, wi_ = cm.x * bb.y + cm.y * bb.x;
          const LAS f32x2* lp = LP + pp * LPD + db;
#pragma unroll
          for (int i = 0; i < 4; ++i) { const f32x2 z = lp[i]; kacc[i] += wr_ * z.x - wi_ * z.y; } }
#pragma unroll
      for (int i = 0; i < 4; ++i) KTG[(db + i) * 256 + h * 16 + hp] = kacc[i]; }
    __syncthreads();
}
__device__ __forceinline__ void s5_assemble(CParams& p, int o) {
    const int g = o >> 16, r = o & 65535;
    const f32x2* LPGg = (const f32x2*)(p.ws + WS_LPG) + (size_t)g * 2 * 33 * 64;
    const f32x2* BBGg = (const f32x2*)(p.ws + WS_BBG) + (size_t)g * 2 * 64 * 16;
    const float* KTGg = (const float*)(p.ws + WS_KTG) + (size_t)g * 2 * 32 * 256;
    float v[8]; bf16_t* dst;
    if (r < 512 * 96) { const int n = r / 96, k8 = r % 96, tau = n >> 4, h = n & 15;
        dst = (bf16_t*)(p.ws + WS_MMAT) + (size_t)g * 512 * 768 + (size_t)n * 768 + k8 * 8;
        if (k8 < 64) { const int sg = k8 >> 1, hb = (k8 & 1) * 8;
            f32x4 a0 = (f32x4){0.f, 0.f, 0.f, 0.f}, a1 = a0;
            if (sg <= tau) { const float* kp = KTGg + ((0 * 32 + (tau - sg)) * 16 + h) * 16 + hb; a0 += *(const f32x4*)kp; a1 += *(const f32x4*)(kp + 4); }
            if (sg >= tau) { const float* kp = KTGg + ((1 * 32 + (sg - tau)) * 16 + h) * 16 + hb; a0 += *(const f32x4*)kp; a1 += *(const f32x4*)(kp + 4); }
#pragma unroll
            for (int j = 0; j < 4; ++j) { v[j] = a0[j]; v[4 + j] = a1[j]; }
            if (sg == tau) { const float dsk = p.s5_d[g * 16 + h];
#pragma unroll
                for (int j = 0; j < 8; ++j) if (hb + j == h) v[j] += dsk; }
        } else { const int q = (k8 - 64) * 8, dir = q >> 7, ri = (q >> 6) & 1, pb = q & 63; const int e = dir == 0 ? (tau + 1) : (TCH - tau);
            const size_t ci = ((size_t)(dir * 32 + g) * 16 + h) * 64 + pb;
            const f32x2* zp = LPGg + (dir * 33 + e) * 64 + pb;
#pragma unroll
            for (int j = 0; j < 8; ++j) { const float cr = p.c_re[ci + j], cim = p.c_im[ci + j]; const f32x2 z = zp[j];
                v[j] = ri == 0 ? (cr * z.x - cim * z.y) : -(cr * z.y + cim * z.x); } }
    } else { const int r2 = r - 512 * 96, n = r2 >> 6, k8 = r2 & 63;
        const int dir = n >> 7, ri = (n >> 6) & 1, pp = n & 63, tau = k8 >> 1, hb = (k8 & 1) * 8;
        dst = (bf16_t*)(p.ws + WS_HMAT) + (size_t)g * 256 * 512 + (size_t)n * 512 + k8 * 8;
        const int e = dir == 0 ? (TCH - 1 - tau) : tau; const f32x2 z = LPGg[(dir * 33 + e) * 64 + pp];
        const f32x2* bp = BBGg + (dir * 64 + pp) * 16 + hb;
#pragma unroll
        for (int j = 0; j < 8; ++j) { const f32x2 bb = bp[j]; v[j] = ri == 0 ? (z.x * bb.x - z.y * bb.y) : (z.x * bb.y + z.y * bb.x); } }
    u32x4 ov; ov.x = cvt_pk_bf16(v[0], v[1]); ov.y = cvt_pk_bf16(v[2], v[3]); ov.z = cvt_pk_bf16(v[4], v[5]); ov.w = cvt_pk_bf16(v[6], v[7]);
    *(u32x4*)dst = ov;
}

__device__ __forceinline__ void norm_store(const f32x4 (&v)[4], const float* gvec, const float* shift, const float* scale, bf16_t* orow, int lane) {
    float s = 0.f;
#pragma unroll
    for (int j = 0; j < 4; ++j) s += (v[j].x * v[j].x + v[j].y * v[j].y) + (v[j].z * v[j].z + v[j].w * v[j].w);
    const float rstd = rsqrtf(wave_sum(s) * (1.0f / D) + 1e-6f);
#pragma unroll
    for (int j = 0; j < 4; ++j) { const int c = 4 * lane + 256 * j;
        const f32x4 gv = *(const f32x4*)(gvec + c), sh = *(const f32x4*)(shift + c), sc = *(const f32x4*)(scale + c);
        const f32x4 y = (v[j] * rstd * gv) * (1.0f + sc) + sh;
        u32x2 w; w.x = cvt_pk_bf16(y.x, y.y); w.y = cvt_pk_bf16(y.z, y.w); *(u32x2*)(orow + c) = w; }
}

#ifndef PH_MASK
#define PH_MASK 0xffffffffu
#endif
#define PH(k) ((PH_MASK >> (k)) & 1u)
#ifndef REP_MASK
#define REP_MASK 0u
#endif
#ifndef EXTRA_SYNCS
#define EXTRA_SYNCS 0
#endif
#define REP(k) ((int)((REP_MASK >> (k)) & 1u) + 1)
__global__ void __launch_bounds__(NTHR, 2) fwd_megakernel(Params p) {
    extern __shared__ __attribute__((aligned(16))) unsigned char lds_raw[];
    LAS unsigned char* lds = (LAS unsigned char*)lds_raw;
    cg::grid_group grid = cg::this_grid();
    const int G = gridDim.x, bid = blockIdx.x, NGW = G * NWAVES;
#define PHASE_IDS int tid = threadIdx.x; asm volatile("" : "+v"(tid)); const int lane = tid & 63, wave = __builtin_amdgcn_readfirstlane(tid >> 6), gw = bid * NWAVES + wave; (void)lane; (void)gw; \
    CParams* pp_ = (CParams*)__builtin_amdgcn_kernarg_segment_ptr(); asm volatile("" : "+s"(pp_)); CParams& p = *pp_; unsigned char* ws = p.ws; \
    bf16_t* WT_in = (bf16_t*)(ws + WS_WIN); bf16_t* WT_out = (bf16_t*)(ws + WS_WOUT); bf16_t* WT_glu = (bf16_t*)(ws + WS_WGLU); bf16_t* WT_1 = (bf16_t*)(ws + WS_W1); bf16_t* WT_2 = (bf16_t*)(ws + WS_W2); bf16_t* WT_pool = (bf16_t*)(ws + WS_WPOOL); float* MOD = (float*)(ws + WS_MOD); float* PR = (float*)(ws + WS_PR); float* PC = (float*)(ws + WS_PC); bf16_t* BUFA = (bf16_t*)(ws + WS_BUFA); float* SLOC = (float*)(ws + WS_SLOC); bf16_t* HB = (bf16_t*)(ws + WS_HB); float* SSQ = (float*)(ws + WS_SSP); float* B1V = (float*)(ws + WS_B1); bf16_t* HD = (bf16_t*)(ws + WS_HD); bf16_t* UG = (bf16_t*)(ws + WS_UG); bf16_t* ZVG = (bf16_t*)(ws + WS_ZVG); bf16_t* YA = (bf16_t*)(ws + WS_YA); bf16_t* MMAT = (bf16_t*)(ws + WS_MMAT); bf16_t* HMAT = (bf16_t*)(ws + WS_HMAT); float* H = p.out; \
    (void)WT_in; (void)WT_out; (void)WT_glu; (void)WT_1; (void)WT_2; (void)WT_pool; (void)MOD; (void)PR; (void)PC; (void)BUFA; (void)SLOC; (void)HB; (void)SSQ; (void)B1V; (void)HD; (void)UG; (void)ZVG; (void)YA; (void)MMAT; (void)HMAT; (void)H;
    unsigned char* ws = p.ws;
    Sched S; S.G = G; S.c = bid;
    unsigned* BAR = (unsigned*)(ws + WS_BAR);
    if (threadIdx.x < 4) ((LAS unsigned*)(lds + LDS_BARST_OFF))[threadIdx.x] = 0u;
    __syncthreads();
    XcdBarrier xbar = xcd_barrier_post(BAR, (volatile LAS unsigned*)(lds + LDS_BARST_OFF));
#define GRID_BAR() xcd_barrier(xbar)

#if PH(0)
    for (int rep_ = 0; rep_ < REP(0); ++rep_) { if (rep_) GRID_BAR(); PHASE_IDS
    for (int it = bid; it < 32; it += G) ada_item(p, lds, it, tid, wave, lane);
    for (int it = bid; it < 256; it += G) s5_part(p, lds, it >> 3, it & 7, tid);
    {
        LAS float* scr = (LAS float*)(lds + wave * 8704);
        constexpr int I_IN = 16 * 48, I_OUT = 16 * 32, I_GLU = 8 * 16, I_1 = 16 * 128, I_2 = 64 * 32, I_P = 4 * 8;
        constexpr int NIT = I_IN + I_OUT + I_GLU + 4 * I_P; (void)I_1; (void)I_2;
        for (int it = gw; it < NIT; it += NGW) { int r = it;
            if (r < I_IN) { transpose_item(p.w_in, 1024, 1536, WT_in, scr, r, lane); continue; } r -= I_IN;
            if (r < I_OUT) { transpose_item(p.w_out, 1024, 1024, WT_out, scr, r, lane); continue; } r -= I_OUT;
            if (r < I_GLU) { transpose_item(p.w_glu, 512, 512, WT_glu, scr, r, lane); continue; } r -= I_GLU;
            { const int gi = r / I_P; transpose_item(p.pool_w + (size_t)gi * 256 * 256, 256, 256, WT_pool + (size_t)gi * 256 * 256, scr, r % I_P, lane); } }
        for (int idx = bid * NTHR + tid; idx < 320 * 512; idx += G * NTHR) { const int pos = idx / 512, cidx = idx % 512, k = cidx & 255;
            const float omega = 1.0f / powf(10000.0f, (float)k / 256.0f); const float posf = pos < 256 ? (float)pos : (float)(pos - 256);
            const float ang = posf * omega; const float v = cidx < 256 ? sinf(ang) : cosf(ang);
            if (pos < 256) PR[pos * 512 + cidx] = v; else PC[(pos - 256) * 512 + cidx] = v; }
    }
    }
#endif
    if (p.cg_sync) grid.sync(); else GRID_BAR();

#if PH(1)
    for (int rep_ = 0; rep_ < REP(1); ++rep_) { if (rep_) GRID_BAR(); PHASE_IDS
    for (int rowb = gw; rowb < MROWS; rowb += 4 * NGW) {
        f32x4 v[4][4];
#pragma unroll
        for (int r = 0; r < 4; ++r) { const int row = rowb + r * NGW;
            if (row < L) { const f32x4* xr = (const f32x4*)(p.x + (size_t)row * D) + lane;
#pragma unroll
                for (int j = 0; j < 4; ++j) v[r][j] = xr[64 * j]; }
            else if (row < MROWS) { const f32x4* xr = (const f32x4*)(p.ctx + (size_t)(row - L) * D) + lane;
#pragma unroll
                for (int j = 0; j < 4; ++j) v[r][j] = xr[64 * j]; } }
#pragma unroll
        for (int r = 0; r < 4; ++r) { const int row = rowb + r * NGW;
            if (row < L) {
#pragma unroll
                for (int j = 0; j < 4; ++j) { const f32x4 pv = j < 2 ? *((const f32x4*)(PR + (size_t)(row >> 6) * 512 + j * 256) + lane) : *((const f32x4*)(PC + (size_t)(row & 63) * 512 + (j - 2) * 256) + lane);
                    v[r][j] += pv; }
                norm_store(v[r], p.norm_mix_g, MOD + 0 * 1024, MOD + 1 * 1024, BUFA + (size_t)row * D, lane); }
            else if (row < MROWS) norm_store(v[r], p.norm_mix_g, MOD + 6144 + 0 * 1024, MOD + 6144 + 1 * 1024, BUFA + (size_t)row * D, lane); }
    }
    }
#endif
    GRID_BAR();

#if PH(2)
    for (int rep_ = 0; rep_ < REP(2); ++rep_) { if (rep_) GRID_BAR(); PHASE_IDS
    { GemmD g{}; g.A = BUFA; g.Bt = WT_in; g.lda = 1024; g.ldb = 1024; g.K = 1024; g.sA = 0; g.sB = 0;
      S.nM = MROWS / 256; S.nN = 6; S.nB = 1; EpiWin E; E.UG = UG; E.ZVG = ZVG; gemm_phase(lds, g, S, E); }
    { int fi = (MROWS / 256) * 6 - G; if (fi < 0 || fi >= G) fi = 0;
      if (bid >= fi) for (int o = (bid - fi) * NTHR + tid; o < 32 * 65536; o += (G - fi) * NTHR) s5_assemble(p, o); }
    }
#endif
    GRID_BAR();

#if PH(3)
    for (int rep_ = 0; rep_ < REP(3); ++rep_) { if (rep_) GRID_BAR(); PHASE_IDS
    { GemmD g{}; g.A = UG; g.Bt = HMAT; g.lda = UGK; g.ldb = 512; g.K = 512; g.sA = (size_t)UGR * UGK; g.sB = (size_t)256 * 512;
      S.nM = 3; S.nN = 1; S.nB = 32; EpiF32Store E; E.C = SLOC; E.ldc = 256; E.sC = (size_t)UGR * 256; for (int grep_ = 0; grep_ < REP(14); ++grep_) { gemm_phase(lds, g, S, E); __syncthreads(); } }
    __syncthreads();
    for (int crep_ = 0; crep_ < REP(13); ++crep_) {   PHASE_IDS
        LAS bf16_t* vbs = (LAS bf16_t*)lds;
        LAS float* outs = (LAS float*)(lds + 62 * 512 * 2);
        const float* cw = p.conv_w;
        for (int it = (G == 256) ? bid : (bid + 160) % G; it < L / 32; it += (G == 256) ? (bid < 96 ? L : 160) : G) { const int t0 = it * 32;
            { u32x4 vv[8], gg[8];
#pragma unroll
              for (int k = 0; k < 8; ++k) { const int idx = tid + k * NTHR, r = idx >> 6, c8 = idx & 63; int t = t0 - 15 + r; t = t < 0 ? 0 : (t > L - 1 ? L - 1 : t);
                  if (idx < 62 * 64) { vv[k] = *(const u32x4*)(ZVG + (size_t)t * 1024 + c8 * 8); gg[k] = *(const u32x4*)(ZVG + (size_t)t * 1024 + 512 + c8 * 8); } }
#pragma unroll
              for (int k = 0; k < 8; ++k) { const int idx = tid + k * NTHR, r = idx >> 6, c8 = idx & 63; const int t = t0 - 15 + r;
                  if (idx < 62 * 64) { u32x4 o = (u32x4){0u, 0u, 0u, 0u};
                      if (t >= 0 && t < L) {
                          o.x = cvt_pk_bf16(bf_lo(vv[k].x) * sigmoidf_(bf_lo(gg[k].x)), bf_hi(vv[k].x) * sigmoidf_(bf_hi(gg[k].x)));
                          o.y = cvt_pk_bf16(bf_lo(vv[k].y) * sigmoidf_(bf_lo(gg[k].y)), bf_hi(vv[k].y) * sigmoidf_(bf_hi(gg[k].y)));
                          o.z = cvt_pk_bf16(bf_lo(vv[k].z) * sigmoidf_(bf_lo(gg[k].z)), bf_hi(vv[k].z) * sigmoidf_(bf_hi(gg[k].z)));
                          o.w = cvt_pk_bf16(bf_lo(vv[k].w) * sigmoidf_(bf_lo(gg[k].w)), bf_hi(vv[k].w) * sigmoidf_(bf_hi(gg[k].w))); }
                      *(LAS u32x4*)(vbs + r * 512 + c8 * 8) = o; } } }
            __syncthreads();
            { const int cp = tid & 255, th = tid >> 8;
              f32x2 a2[16];
#pragma unroll
              for (int o = 0; o < 16; ++o) a2[o] = (f32x2){0.f, 0.f};
              f32x2 wv[31];
              const float* cwp = cw + 2 * cp; asm volatile("" : "+v"(cwp));
#pragma unroll
              for (int k = 0; k < 31; ++k) wv[k] = *(const f32x2*)(cwp + k * 512);
#pragma unroll
              for (int j = 0; j < 46; ++j) { const unsigned xw = *(const LAS unsigned*)(vbs + (th * 16 + j) * 512 + 2 * cp); const f32x2 x2 = (f32x2){bf_lo(xw), bf_hi(xw)};
#pragma unroll
                  for (int o = 0; o < 16; ++o) { const int k = j - o; if (k >= 0 && k <= 30) a2[o] = __builtin_elementwise_fma(wv[k], x2, a2[o]); } }
              const f32x2 cb = *(const f32x2*)(p.conv_b + 2 * cp);
#pragma unroll
              for (int o = 0; o < 16; ++o) *(LAS f32x2*)(outs + (th * 16 + o) * 512 + 2 * cp) = a2[o] + cb; }
            __syncthreads();
#pragma unroll
            for (int q = 0; q < 4; ++q) { const int to = wave * 4 + q;
                const f32x4 y0 = *(const LAS f32x4*)(outs + to * 512 + lane * 8), y1 = *(const LAS f32x4*)(outs + to * 512 + lane * 8 + 4);
                const float mean = wave_sum((y0.x + y0.y) + (y0.z + y0.w) + (y1.x + y1.y) + (y1.z + y1.w)) * (1.0f / 512.0f);
                const f32x4 d0 = y0 - mean, d1 = y1 - mean;
                const float var = wave_sum((d0.x * d0.x + d0.y * d0.y) + (d0.z * d0.z + d0.w * d0.w) + (d1.x * d1.x + d1.y * d1.y) + (d1.z * d1.z + d1.w * d1.w)) * (1.0f / 512.0f);
                const float rstd = rsqrtf(var + 1e-6f);
                const f32x4 g0 = *(const f32x4*)(p.ln_g + lane * 8), g1 = *(const f32x4*)(p.ln_g + lane * 8 + 4), b0 = *(const f32x4*)(p.ln_b + lane * 8), b1 = *(const f32x4*)(p.ln_b + lane * 8 + 4);
                f32x4 z0 = d0 * rstd * g0 + b0, z1 = d1 * rstd * g1 + b1;
#pragma unroll
                for (int j = 0; j < 4; ++j) { z0[j] = z0[j] * sigmoidf_(z0[j]); z1[j] = z1[j] * sigmoidf_(z1[j]); }
                u32x4 w; w.x = cvt_pk_bf16(z0.x, z0.y); w.y = cvt_pk_bf16(z0.z, z0.w); w.z = cvt_pk_bf16(z1.x, z1.y); w.w = cvt_pk_bf16(z1.z, z1.w);
                *(u32x4*)(BUFA + (size_t)(t0 + to) * 1024 + 512 + lane * 8) = w; }
            __syncthreads();
        }
    }
    }
#endif
    GRID_BAR();

#if PH(4)
    for (int rep_ = 0; rep_ < REP(4); ++rep_) { if (rep_) GRID_BAR(); PHASE_IDS
    if (bid >= 64 && G > 64) { for (int i2 = bid - 64; i2 < 160; i2 += G - 64) ada_item(p, lds, i2 < 64 ? 32 + i2 : 32 + i2, tid, wave, lane); }
    else if (G <= 64) { for (int i2 = bid; i2 < 160; i2 += G) ada_item(p, lds, 32 + i2, tid, wave, lane); }
    if (bid >= 64 && G > 64) mlp_transposes(p, lds, 0, 4096, (bid - 64) * NWAVES + wave, (G - 64) * NWAVES, wave, lane);
    else if (G <= 64) mlp_transposes(p, lds, 0, 4096, gw, NGW, wave, lane);
    for (int it = bid; it < 64; it += G) { const int g = it >> 1, dir = it & 1;
        LAS f32x2* EX = (LAS f32x2*)lds;
        const f32x2 lam = ((const f32x2*)(ws + WS_LAMT))[(g * 2 + dir) * 64 + lane];
        float pr = lam.x, pi = lam.y;
#pragma unroll
        for (int q = 0; q < 6; ++q) { const float nr = pr * pr - pi * pi, ni = 2.0f * pr * pi; pr = nr; pi = ni; }
        const float* sl = SLOC + (size_t)g * UGR * 256 + dir * 128 + lane;
        bf16_t* ug = UG + (size_t)g * UGR * UGK + 512 + dir * 128 + lane;
        const long sstp = dir == 0 ? 256 : -256, ustp = dir == 0 ? UGK : -UGK; const int ch0 = dir == 0 ? wave * 64 : NCH - 1 - wave * 64;
        float sr = 0.f, si = 0.f;
        if (wave == 0) {
            float cr[8], ci[8];
#pragma unroll
            for (int q = 0; q < 8; ++q) { const int ch = dir == 0 ? NCH + q : NCH + 7 - q; cr[q] = sl[(size_t)ch * 256]; ci[q] = sl[(size_t)ch * 256 + 64]; }
#pragma unroll
            for (int q = 0; q < 8; ++q) { const float nr = lam.x * sr - lam.y * si + cr[q], ni = lam.x * si + lam.y * sr + ci[q]; sr = nr; si = ni; } }
        float ir = sr, ii = si;
        { const float* sp = sl + (size_t)ch0 * 256;
#pragma unroll 1
          for (int jb = 0; jb < 4; ++jb) { float br[16], bi[16];
#pragma unroll
              for (int j = 0; j < 16; ++j) { br[j] = sp[(long)j * sstp]; bi[j] = sp[(long)j * sstp + 64]; }
#pragma unroll
              for (int j = 0; j < 16; ++j) { const float nr = lam.x * sr - lam.y * si + br[j], ni = lam.x * si + lam.y * sr + bi[j]; sr = nr; si = ni; }
              sp += 16 * sstp; } }
        EX[wave * 64 + lane] = (f32x2){sr, si};
        __syncthreads();
        if (wave > 0) { f32x2 f = EX[lane];
            for (int j = 1; j < wave; ++j) { const f32x2 e = EX[j * 64 + lane]; const float nr = pr * f.x - pi * f.y + e.x, ni = pr * f.y + pi * f.x + e.y; f.x = nr; f.y = ni; }
            ir = f.x; ii = f.y; }
        sr = ir; si = ii;
        { const float* sp = sl + (size_t)ch0 * 256; bf16_t* up = ug + (size_t)ch0 * UGK;
#pragma unroll 1
          for (int jb = 0; jb < 4; ++jb) { float br[16], bi[16];
#pragma unroll
              for (int j = 0; j < 16; ++j) { br[j] = sp[(long)j * sstp]; bi[j] = sp[(long)j * sstp + 64]; }
#pragma unroll
              for (int j = 0; j < 16; ++j) { const unsigned w = cvt_pk_bf16(sr, si);
                  up[(long)j * ustp] = (bf16_t)(w & 0xffffu); up[(long)j * ustp + 64] = (bf16_t)(w >> 16);
                  const float nr = lam.x * sr - lam.y * si + br[j], ni = lam.x * si + lam.y * sr + bi[j]; sr = nr; si = ni; }
              sp += 16 * sstp; up += 16 * ustp; } }
        __syncthreads();
    }
    }
#endif
    GRID_BAR();

#if PH(5)
    for (int rep_ = 0; rep_ < REP(5); ++rep_) { if (rep_) GRID_BAR(); PHASE_IDS
    { GemmD g{}; g.A = UG; g.Bt = MMAT; g.lda = UGK; g.ldb = 768; g.K = 768; g.sA = (size_t)UGR * UGK; g.sB = (size_t)512 * 768;
      S.nM = 2; S.nN = 2; S.nB = 32; EpiY E; E.YA = YA; gemm_phase(lds, g, S, E); }
    if (bid >= 128 && G > 128) mlp_transposes(p, lds, 4096, 2048, (bid - 128) * NWAVES + wave, (G - 128) * NWAVES, wave, lane);
    else if (G <= 128) { __syncthreads(); mlp_transposes(p, lds, 4096, 2048, gw, NGW, wave, lane); }
    }
#endif
    GRID_BAR();

#if PH(6)
    for (int rep_ = 0; rep_ < REP(6); ++rep_) { if (rep_) GRID_BAR(); PHASE_IDS
    { GemmD g{}; g.A = YA; g.Bt = WT_glu; g.lda = 512; g.ldb = 512; g.K = 512; g.sA = 0; g.sB = 0;
      S.nM = L / 256; S.nN = 2; S.nB = 1; EpiGlu E; E.YA = YA; E.A1 = BUFA; gemm_phase(lds, g, S, E); }
    if (bid >= 128 && G > 128) mlp_transposes(p, lds, 6144, 2048, (bid - 128) * NWAVES + wave, (G - 128) * NWAVES, wave, lane);
    else if (G <= 128) { __syncthreads(); mlp_transposes(p, lds, 6144, 2048, gw, NGW, wave, lane); }
    }
#endif
    GRID_BAR();

#if PH(7)
    for (int rep_ = 0; rep_ < REP(7); ++rep_) { if (rep_) GRID_BAR(); PHASE_IDS
    { GemmD g{}; g.A = BUFA; g.Bt = WT_out; g.lda = 1024; g.ldb = 1024; g.K = 1024; g.sA = 0; g.sB = 0;
      S.nM = L / 256; S.nN = 4; S.nB = 1; EpiWout E; E.x = p.x; E.PR = PR; E.PC = PC; E.g1 = MOD + 2 * 1024; E.H = H; E.HB = HB; E.SSP = SSQ; gemm_phase(lds, g, S, E); }
    }
#endif
    GRID_BAR();

#define mod (MOD + (layer == 0 ? 0 : 2 * 6144))
    { constexpr int layer = 0;
#if PH(11)
    for (int rep_ = 0; rep_ < REP(11); ++rep_) { if (rep_) GRID_BAR(); PHASE_IDS
        { GemmD g{}; g.A = HB; g.Bt = WT_1 + (size_t)layer * 4096 * 1024; g.lda = 1024; g.ldb = 1024; g.K = 1024; g.sA = 0; g.sB = 0;
          S.nM = L / 256; S.nN = 16; S.nB = 1; EpiMlp1 E; E.HD = HD; E.SS = SSQ + (size_t)layer * L * 16; E.B1 = B1V + layer * DFF; gemm_phase(lds, g, S, E); }
    }
#endif
        GRID_BAR();
#if PH(12)
    for (int rep_ = 0; rep_ < REP(12); ++rep_) { if (rep_) GRID_BAR(); PHASE_IDS
        { GemmD g{}; g.A = HD; g.Bt = WT_2 + (size_t)layer * 1024 * 4096; g.lda = 4096; g.ldb = 4096; g.K = 4096; g.sA = 0; g.sB = 0;
          S.nM = L / 256; S.nN = 4; S.nB = 1; EpiMlp2<false> E; E.g2 = mod + 5 * 1024; E.HB = HB; E.OUT = H; gemm_phase(lds, g, S, E); }
    }
#endif
        GRID_BAR();
    }
    { constexpr int layer = 1;
#if PH(8)
    for (int rep_ = 0; rep_ < REP(8); ++rep_) { if (rep_) GRID_BAR(); PHASE_IDS
            LAS bf16_t* ns = (LAS bf16_t*)lds;
            for (int it = bid; it < L / 32; it += G) { const int t0 = it * 32;
                for (int rb = wave; rb < 47; rb += 3 * NWAVES) { u32x4 v[3][2];
#pragma unroll
                    for (int q = 0; q < 3; ++q) { const int r = rb + q * NWAVES; int t = t0 - 8 + r; t = t < 0 ? 0 : (t > L - 1 ? L - 1 : t);
                        if (r < 47) { const u32x4* hr = (const u32x4*)(HB + (size_t)t * D) + lane; v[q][0] = hr[0]; v[q][1] = hr[64]; } }
#pragma unroll
                    for (int q = 0; q < 3; ++q) { const int r = rb + q * NWAVES; const int t = t0 - 8 + r;
                        if (r < 47) {
                            if (t >= 0 && t < L) { float f[2][8]; float s = 0.f;
#pragma unroll
                                for (int j = 0; j < 2; ++j) { f[j][0] = bf_lo(v[q][j].x); f[j][1] = bf_hi(v[q][j].x); f[j][2] = bf_lo(v[q][j].y); f[j][3] = bf_hi(v[q][j].y);
                                    f[j][4] = bf_lo(v[q][j].z); f[j][5] = bf_hi(v[q][j].z); f[j][6] = bf_lo(v[q][j].w); f[j][7] = bf_hi(v[q][j].w);
#pragma unroll
                                    for (int e = 0; e < 8; ++e) s += f[j][e] * f[j][e]; }
                                const float rstd = rsqrtf(wave_sum(s) * (1.0f / D) + 1e-6f);
#pragma unroll
                                for (int j = 0; j < 2; ++j) { const int c = 8 * lane + 512 * j; float y[8];
#pragma unroll
                                    for (int hq = 0; hq < 2; ++hq) { const f32x4 gv = *(const f32x4*)(p.norm_mix_g + D + c + 4 * hq), sh = *(const f32x4*)(mod + c + 4 * hq), sc = *(const f32x4*)(mod + 1024 + c + 4 * hq);
#pragma unroll
                                        for (int e = 0; e < 4; ++e) y[4 * hq + e] = (f[j][4 * hq + e] * rstd * gv[e]) * (1.0f + sc[e]) + sh[e]; }
                                    u32x4 w; w.x = cvt_pk_bf16(y[0], y[1]); w.y = cvt_pk_bf16(y[2], y[3]); w.z = cvt_pk_bf16(y[4], y[5]); w.w = cvt_pk_bf16(y[6], y[7]);
                                    *(LAS u32x4*)(ns + r * 1024 + c) = w; }
                            } else {
#pragma unroll
                                for (int j = 0; j < 2; ++j) *(LAS u32x4*)(ns + r * 1024 + 8 * lane + 512 * j) = (u32x4){0u, 0u, 0u, 0u}; } } } }
                __syncthreads();
                { const int gi = tid >> 7, win = 2 << gi, left = win >> 1, right = win - 1 - left;
                  float s0 = 0.f, s1 = 0.f;
                  for (int r = 8 - left; r <= 8 + right; ++r) { const unsigned w = *(const LAS unsigned*)(ns + r * 1024 + 2 * tid); s0 += bf_lo(w); s1 += bf_hi(w); }
                  for (int to = 0; to < 32; ++to) { const int t = t0 + to;
                      if (to > 0) { const unsigned wn = *(const LAS unsigned*)(ns + (to + 8 + right) * 1024 + 2 * tid), wo = *(const LAS unsigned*)(ns + (to + 7 - left) * 1024 + 2 * tid);
                          s0 += bf_lo(wn) - bf_lo(wo); s1 += bf_hi(wn) - bf_hi(wo); }
                      const unsigned ws_ = *(const LAS unsigned*)(ns + (to + 8) * 1024 + 2 * tid);
                      const int lo = max(t - left, 0), hi = min(t + right, L - 1); const float inv = 1.0f / (float)(hi - lo + 1);
                      *(unsigned*)(BUFA + (size_t)t * 1024 + 2 * tid) = cvt_pk_bf16(s0 * inv - bf_lo(ws_), s1 * inv - bf_hi(ws_)); } }
                __syncthreads();
            }
    }
#endif
            GRID_BAR();
#if PH(9)
    for (int rep_ = 0; rep_ < REP(9); ++rep_) { if (rep_) GRID_BAR(); PHASE_IDS
            { GemmD g{}; g.A = BUFA; g.Bt = WT_pool; g.lda = 1024; g.ldb = 256; g.K = 256; g.sA = 256; g.sB = (size_t)256 * 256;
              S.nM = L / 256; S.nN = 1; S.nB = 4; EpiPool E; E.g1 = mod + 2 * 1024; E.pb = p.pool_b; E.ps = p.pool_scale; E.H = H; E.HB = HB; E.SSP = SSQ + (size_t)L * 16; gemm_phase(lds, g, S, E); }
    }
#endif
            GRID_BAR();
#if PH(11)
    for (int rep_ = 0; rep_ < REP(11); ++rep_) { if (rep_) GRID_BAR(); PHASE_IDS
        { GemmD g{}; g.A = HB; g.Bt = WT_1 + (size_t)layer * 4096 * 1024; g.lda = 1024; g.ldb = 1024; g.K = 1024; g.sA = 0; g.sB = 0;
          S.nM = L / 256; S.nN = 16; S.nB = 1; EpiMlp1 E; E.HD = HD; E.SS = SSQ + (size_t)layer * L * 16; E.B1 = B1V + layer * DFF; gemm_phase(lds, g, S, E); }
    }
#endif
        GRID_BAR();
#if PH(12)
    for (int rep_ = 0; rep_ < REP(12); ++rep_) { if (rep_) GRID_BAR(); PHASE_IDS
        { GemmD g{}; g.A = HD; g.Bt = WT_2 + (size_t)layer * 1024 * 4096; g.lda = 4096; g.ldb = 4096; g.K = 4096; g.sA = 0; g.sB = 0;
          S.nM = L / 256; S.nN = 4; S.nB = 1; EpiMlp2<true> E; E.g2 = mod + 5 * 1024; E.HB = HB; E.OUT = H; gemm_phase(lds, g, S, E); }
    }
#endif
        GRID_BAR();
    }

    for (int es_ = 0; es_ < EXTRA_SYNCS; ++es_) GRID_BAR();
    { PHASE_IDS
    for (int rowb = gw; rowb < L; rowb += 4 * NGW) { f32x4 v[4][4];
#pragma unroll
        for (int r = 0; r < 4; ++r) { const int row = rowb + r * NGW; if (row < L) { const f32x4* hr = (const f32x4*)(H + (size_t)row * D) + lane;
#pragma unroll
            for (int j = 0; j < 4; ++j) v[r][j] = hr[64 * j]; } }
#pragma unroll
        for (int r = 0; r < 4; ++r) { const int row = rowb + r * NGW; if (row < L) { f32x4* hr = (f32x4*)(H + (size_t)row * D) + lane; float s = 0.f;
#pragma unroll
            for (int j = 0; j < 4; ++j) s += (v[r][j].x * v[r][j].x + v[r][j].y * v[r][j].y) + (v[r][j].z * v[r][j].z + v[r][j].w * v[r][j].w);
            const float rstd = rsqrtf(wave_sum(s) * (1.0f / D) + 1e-6f);
#pragma unroll
            for (int j = 0; j < 4; ++j) { const f32x4 gv = *((const f32x4*)p.final_g + lane + 64 * j); hr[64 * j] = v[r][j] * rstd * gv; } } } }
    }
}

extern "C" void kernel_launch(void* const* d_in, const int* in_sizes, int n_in, void* d_out, int out_size, void* d_ws, size_t ws_size, hipStream_t stream) {
    static int grid_blocks = 0;
    if (grid_blocks == 0) {
        int dev = 0, cus = 0, per_cu = 0;
        if (hipGetDevice(&dev) != hipSuccess || hipDeviceGetAttribute(&cus, hipDeviceAttributeMultiprocessorCount, dev) != hipSuccess) { fprintf(stderr, "kernel_launch: device query failed\n"); grid_blocks = -1; return; }
        if (hipFuncSetAttribute((const void*)fwd_megakernel, hipFuncAttributeMaxDynamicSharedMemorySize, LDS_BYTES) != hipSuccess) { fprintf(stderr, "kernel_launch: hipFuncSetAttribute failed\n"); grid_blocks = -1; return; }
        if (hipOccupancyMaxActiveBlocksPerMultiprocessor(&per_cu, (const void*)fwd_megakernel, NTHR, LDS_BYTES) != hipSuccess || per_cu < 1) { fprintf(stderr, "kernel_launch: occupancy query says %d blocks per CU\n", per_cu); (void)hipGetLastError(); }
        if (ws_size < WS_END || n_in != 29 || out_size != L * D) { fprintf(stderr, "kernel_launch: unexpected sizes (ws %zu need %zu, n_in %d, out %d)\n", ws_size, (size_t)WS_END, n_in, out_size); grid_blocks = -1; return; }
        grid_blocks = cus;
    }
    if (grid_blocks < 0) return;
    Params p{};
    const float** f = (const float**)&p;
    for (int i = 0; i < 29; ++i) f[i] = (const float*)d_in[i];
    p.out = (float*)d_out; p.ws = (unsigned char*)d_ws; p.cg_sync = 0; p.pad = 0;
    if (hipMemsetAsync((unsigned char*)d_ws + WS_SS, 0, WS_ACC_BYTES, stream) != hipSuccess) { fprintf(stderr, "kernel_launch: hipMemsetAsync of the accumulators failed\n"); return; }
    if (hipMemsetAsync((unsigned char*)d_ws + WS_BAR, 0, (size_t)XCD_BAR_WORDS_C * 4, stream) != hipSuccess) { fprintf(stderr, "kernel_launch: hipMemsetAsync of the barrier words failed\n"); return; }
    void* args[] = {&p};
    hipError_t e = hipLaunchCooperativeKernel((const void*)fwd_megakernel, dim3(grid_blocks), dim3(NTHR), args, LDS_BYTES, stream);
    if (e != hipSuccess) fprintf(stderr, "cooperative launch failed: %s (grid %d)\n", hipGetErrorString(e), grid_blocks);
}
```
